# Optimizing an MI355X kernel written in HIP

```python
import math
import jax
import jax.numpy as jnp
from jax import lax
import numpy as np

D_MODEL = 1024
BATCH = 8
SEQ = 2048
DEPTH = 4

FFN_DIM = 2816
BRANCH_WIDTH = 512
N_BRANCH = 4
SGU_WIDTH = BRANCH_WIDTH
SGU_GROUPS = 4
SGU_CHUNK = 128
SSM_HEADS = 8
SSM_HEAD_DIM = 64
SSM_INNER = SSM_HEADS * SSM_HEAD_DIM
SSM_GROUPS = 2
SSM_STATE = 128
SSM_CONV = 4
SSM_CHUNK = 128
SSM_CONV_DIM = SSM_INNER + 2 * SSM_GROUPS * SSM_STATE
NSA_HEADS = 8
NSA_KV_GROUPS = 2
NSA_HEAD_DIM = 64
NSA_WIDTH = NSA_HEADS * NSA_HEAD_DIM
CMP_BLOCK = 32
CMP_STRIDE = 16
CMP_HIDDEN = 128
SEL_BLOCK = 64
SEL_TOP_N = 8
WINDOW = 256
Q_BLOCK = 128
CONV_WIDTH = BRANCH_WIDTH
CONV_KERNEL = 31
EPS = 1e-6
NEG = -1e30
FORCE = 1e9
NSA_KV_WIDTH = NSA_KV_GROUPS * NSA_HEAD_DIM
SPLIT_SIZES = (2 * SGU_WIDTH, SSM_INNER, SSM_CONV_DIM, SSM_HEADS, NSA_WIDTH,
               NSA_KV_WIDTH, NSA_KV_WIDTH, NSA_KV_WIDTH, NSA_KV_WIDTH, NSA_KV_WIDTH, NSA_KV_WIDTH,
               3 * NSA_HEADS, 2 * CONV_WIDTH, N_BRANCH * D_MODEL)
IN_PROJ_DIM = 2 * SGU_WIDTH + SSM_INNER + SSM_CONV_DIM + SSM_HEADS + NSA_WIDTH + 6 * NSA_KV_WIDTH + 3 * NSA_HEADS + 2 * CONV_WIDTH + N_BRANCH * D_MODEL

kernel_name = "hybrid_sgu_ssd_nsa_conformer_macaron"


def rms_norm(x, g):
    xf = x.astype(jnp.float32)
    y = xf * lax.rsqrt(jnp.mean(xf * xf, axis=-1, keepdims=True) + EPS)
    return (y * g.astype(jnp.float32)).astype(x.dtype)


def swiglu(x, w_in, w_out):
    gate, up = jnp.split(x @ w_in, 2, axis=-1)
    return (jax.nn.silu(gate) * up) @ w_out


def causal_depthwise_conv(x, w, b):
    k, c = w.shape
    y = lax.conv_general_dilated(x, w[:, None, :].astype(x.dtype), window_strides=(1,),
                                 padding=[(k - 1, 0)], dimension_numbers=("NWC", "WIO", "NWC"),
                                 feature_group_count=c)
    return y + b.astype(x.dtype)


def alibi_slopes(n):
    return np.array([2.0 ** (-8.0 * (i + 1) / n) for i in range(n)], dtype=np.float32)


def segsum(a):
    t = a.shape[-1]
    ar = jnp.broadcast_to(a[..., :, None], a.shape + (t,))
    cs = jnp.cumsum(jnp.where(jnp.tril(jnp.ones((t, t), bool), -1), ar, 0.0), axis=-2)
    return jnp.where(jnp.tril(jnp.ones((t, t), bool)), cs, -jnp.inf)


def ssd_scan(x, a, b, c):
    bsz, s, h, p = x.shape
    n = b.shape[-1]
    nc = s // SSM_CHUNK
    x = x.reshape(bsz, nc, SSM_CHUNK, h, p)
    b = b.reshape(bsz, nc, SSM_CHUNK, h, n)
    c = c.reshape(bsz, nc, SSM_CHUNK, h, n)
    a = a.reshape(bsz, nc, SSM_CHUNK, h).transpose(0, 3, 1, 2)
    a_cs = jnp.cumsum(a, axis=-1)
    scores = jnp.einsum("bclhn,bcshn->bhcls", c, b) * jnp.exp(segsum(a))
    y_diag = jnp.einsum("bhcls,bcshp->bclhp", scores, x)
    decay_states = jnp.exp(a_cs[..., -1:] - a_cs)
    states = jnp.einsum("bclhn,bhcl,bclhp->bchpn", b, decay_states, x)
    states = jnp.concatenate([jnp.zeros_like(states[:, :1]), states], axis=1)
    decay_chunk = jnp.exp(segsum(jnp.pad(a_cs[..., -1], ((0, 0), (0, 0), (1, 0)))))
    states = jnp.einsum("bhzc,bchpn->bzhpn", decay_chunk, states)[:, :-1]
    y_off = jnp.einsum("bclhn,bchpn,bhcl->bclhp", c, states, jnp.exp(a_cs))
    return (y_diag + y_off).reshape(bsz, s, h, p)


def sgu_mixer(uv, v_norm, w_s, b_s):
    bsz, s, _ = uv.shape
    u, v = jnp.split(jax.nn.gelu(uv), 2, axis=-1)
    v = rms_norm(v, v_norm).reshape(bsz, s // SGU_CHUNK, SGU_CHUNK, SGU_GROUPS, SGU_WIDTH // SGU_GROUPS)
    w = w_s * jnp.tril(jnp.ones((SGU_CHUNK, SGU_CHUNK), w_s.dtype))
    mixed = jnp.einsum("gts,bcsgd->bctgd", w, v) + b_s.T[None, None, :, :, None]
    return u * mixed.reshape(bsz, s, SGU_WIDTH)


def mamba2_mixer(z, xbc, dt, conv_w, conv_b, dt_bias, a_log, d_skip, norm_g):
    bsz, s, _ = z.shape
    f32 = jnp.float32
    xbc = jax.nn.silu(causal_depthwise_conv(xbc, conv_w, conv_b))
    xs, bm, cm = jnp.split(xbc, [SSM_INNER, SSM_INNER + SSM_GROUPS * SSM_STATE], axis=-1)
    rep = SSM_HEADS // SSM_GROUPS
    xs = xs.reshape(bsz, s, SSM_HEADS, SSM_HEAD_DIM).astype(f32)
    bm = jnp.repeat(bm.reshape(bsz, s, SSM_GROUPS, SSM_STATE).astype(f32), rep, axis=2)
    cm = jnp.repeat(cm.reshape(bsz, s, SSM_GROUPS, SSM_STATE).astype(f32), rep, axis=2)
    dt = jax.nn.softplus(dt.astype(f32) + dt_bias.astype(f32))
    a = -jnp.exp(a_log.astype(f32))
    y = ssd_scan(xs * dt[..., None], dt * a, bm, cm)
    y = (y + xs * d_skip.astype(f32)[:, None]).reshape(bsz, s, SSM_INNER)
    return rms_norm(y * jax.nn.silu(z.astype(f32)), norm_g).astype(z.dtype)


def nsa_mixer(q, kc, vc, ks, vs, kw, vw, gate, q_norm, k_norm,
              pe_k, w1_k, w2_k, pe_v, w1_v, w2_v):
    bsz, s, _ = q.shape
    G, R, E = NSA_KV_GROUPS, NSA_HEADS // NSA_KV_GROUPS, NSA_HEAD_DIM
    f32 = jnp.float32
    n_blk = s // Q_BLOCK
    n_cmp = (s - CMP_BLOCK) // CMP_STRIDE + 1
    n_sel = s // SEL_BLOCK
    top_n = min(SEL_TOP_N, n_sel)
    slopes = jnp.asarray(alibi_slopes(NSA_HEADS).reshape(G, R))

    def kv(t):
        return t.reshape(bsz, s, G, E)

    q = rms_norm(q.reshape(bsz, s, G, R, E), q_norm) * (E ** -0.5)
    ks = rms_norm(kv(ks), k_norm)
    kw = rms_norm(kv(kw), k_norm)

    cidx = np.arange(n_cmp)[:, None] * CMP_STRIDE + np.arange(CMP_BLOCK)[None, :]

    def compress(k, pe, w1, w2):
        blk = k[:, cidx] + pe[:, None, :]
        blk = blk.transpose(0, 1, 3, 2, 4).reshape(bsz, n_cmp, G, CMP_BLOCK * E)
        return jax.nn.gelu(blk @ w1) @ w2

    k_cmp = rms_norm(compress(kv(kc), pe_k, w1_k, w2_k), k_norm)
    v_cmp = compress(kv(vc), pe_v, w1_v, w2_v)
    c_start = np.arange(n_cmp) * CMP_STRIDE
    c_last = jnp.asarray(c_start + CMP_BLOCK - 1)
    c_mid = jnp.asarray((c_start + (CMP_BLOCK - 1) / 2.0).astype(np.float32))
    s_start = np.arange(n_sel) * SEL_BLOCK
    overlap = jnp.asarray(((c_start[:, None] <= s_start[None, :] + SEL_BLOCK - 1)
                           & (c_start[:, None] + CMP_BLOCK - 1 >= s_start[None, :])).astype(np.float32))

    ksb = ks.reshape(bsz, n_sel, SEL_BLOCK, G, E).transpose(0, 3, 1, 2, 4)
    vsb = kv(vs).reshape(bsz, n_sel, SEL_BLOCK, G, E).transpose(0, 3, 1, 2, 4)
    kw_pad = jnp.pad(kw, ((0, 0), (WINDOW, 0), (0, 0), (0, 0)))
    vw_pad = jnp.pad(kv(vw), ((0, 0), (WINDOW, 0), (0, 0), (0, 0)))
    bi = jnp.arange(bsz)[:, None, None, None]
    gi = jnp.arange(G)[None, :, None, None]
    sel_ids = jnp.arange(n_sel)

    def block(args):
        j, qb, gb = args
        t = j * Q_BLOCK + jnp.arange(Q_BLOCK)
        tf = t.astype(f32)
        mask_c = c_last[None, :] <= t[:, None]
        s_c = jnp.einsum("bqgrd,bcgd->bgrqc", qb, k_cmp).astype(f32) \
            - slopes[:, :, None, None] * (tf[:, None] - c_mid[None, :])
        p_c = jax.nn.softmax(jnp.where(mask_c, s_c, NEG), axis=-1) * mask_c
        o_c = jnp.einsum("bgrqc,bcgd->bqgrd", p_c.astype(v_cmp.dtype), v_cmp)
        imp = jnp.einsum("bgrqc,cn->bgqn", p_c, overlap)
        cur = (t // SEL_BLOCK)[:, None]
        forced = (sel_ids == 0) | (sel_ids == cur) | (sel_ids == cur - 1)
        valid = sel_ids * SEL_BLOCK <= t[:, None]
        score = jnp.where(forced, FORCE, jnp.where(valid, imp, NEG))
        _, idx = lax.top_k(score, top_n)
        kb = ksb[bi, gi, idx]
        vb = vsb[bi, gi, idx]
        pos = idx[..., None] * SEL_BLOCK + jnp.arange(SEL_BLOCK)
        rel_s = t[None, None, :, None, None] - pos
        s_s = jnp.einsum("bqgrd,bgqnld->bgrqnl", qb, kb).astype(f32) \
            - slopes[:, :, None, None, None] * rel_s[:, :, None].astype(f32)
        s_s = jnp.where((rel_s >= 0)[:, :, None], s_s, NEG).reshape(bsz, G, R, Q_BLOCK, top_n * SEL_BLOCK)
        p_s = jax.nn.softmax(s_s, axis=-1).reshape(bsz, G, R, Q_BLOCK, top_n, SEL_BLOCK)
        o_s = jnp.einsum("bgrqnl,bgqnld->bqgrd", p_s.astype(vb.dtype), vb)
        kwin = lax.dynamic_slice_in_dim(kw_pad, j * Q_BLOCK, Q_BLOCK + WINDOW, axis=1)
        vwin = lax.dynamic_slice_in_dim(vw_pad, j * Q_BLOCK, Q_BLOCK + WINDOW, axis=1)
        kpos = j * Q_BLOCK - WINDOW + jnp.arange(Q_BLOCK + WINDOW)
        rel_w = t[:, None] - kpos[None, :]
        mask_w = (rel_w >= 0) & (rel_w < WINDOW) & (kpos[None, :] >= 0)
        s_w = jnp.einsum("bqgrd,bkgd->bgrqk", qb, kwin).astype(f32) \
            - slopes[:, :, None, None] * rel_w.astype(f32)
        p_w = jax.nn.softmax(jnp.where(mask_w, s_w, NEG), axis=-1)
        o_w = jnp.einsum("bgrqk,bkgd->bqgrd", p_w.astype(vwin.dtype), vwin)
        return gb[..., 0:1] * o_c + gb[..., 1:2] * o_s + gb[..., 2:3] * o_w

    qbs = q.reshape(bsz, n_blk, Q_BLOCK, G, R, E).swapaxes(0, 1)
    gbs = jax.nn.sigmoid(gate).reshape(bsz, n_blk, Q_BLOCK, G, R, 3).swapaxes(0, 1)
    out = lax.map(block, (jnp.arange(n_blk), qbs, gbs))
    return out.swapaxes(0, 1).reshape(bsz, s, NSA_WIDTH)


def conv_module(ab, dw_w, dw_b, norm_g):
    a, b = jnp.split(ab, 2, axis=-1)
    y = causal_depthwise_conv(a * jax.nn.sigmoid(b), dw_w, dw_b)
    return jax.nn.silu(rms_norm(y, norm_g))


def setup_inputs(seed: int = 0) -> dict:
    key = jax.random.key(seed)
    keys = jax.random.split(key, 48)
    count = [0]
    L = DEPTH

    def nxt():
        k = keys[count[0]]
        count[0] += 1
        return k

    def nrm(shape, scale):
        return jax.random.normal(nxt(), shape, jnp.float32) * scale

    def gain(n):
        return 1.0 + nrm((L, n), 0.02)

    dt0 = jnp.exp(jax.random.uniform(nxt(), (L, SSM_HEADS), jnp.float32, math.log(1e-3), math.log(1e-1)))
    cmp_in = CMP_BLOCK * NSA_HEAD_DIM
    return {
        "x": nrm((BATCH, SEQ, D_MODEL), 1.0),
        "ffn1_norm": gain(D_MODEL),
        "ffn1_w_in": nrm((L, D_MODEL, 2 * FFN_DIM), D_MODEL ** -0.5),
        "ffn1_w_out": nrm((L, FFN_DIM, D_MODEL), FFN_DIM ** -0.5),
        "mix_norm": gain(D_MODEL),
        "w_in": nrm((L, D_MODEL, IN_PROJ_DIM), D_MODEL ** -0.5),
        "sgu_v_norm": gain(SGU_WIDTH),
        "sgu_w": nrm((L, SGU_GROUPS, SGU_CHUNK, SGU_CHUNK), SGU_CHUNK ** -0.5),
        "sgu_b": 1.0 + nrm((L, SGU_GROUPS, SGU_CHUNK), 0.1),
        "ssm_conv_w": nrm((L, SSM_CONV, SSM_CONV_DIM), SSM_CONV ** -0.5),
        "ssm_conv_b": nrm((L, SSM_CONV_DIM), 0.01),
        "ssm_dt_bias": dt0 + jnp.log(-jnp.expm1(-dt0)),
        "ssm_a_log": jnp.log(jax.random.uniform(nxt(), (L, SSM_HEADS), jnp.float32, 1.0, 16.0)),
        "ssm_d": 1.0 + nrm((L, SSM_HEADS), 0.1),
        "ssm_norm": gain(SSM_INNER),
        "nsa_q_norm": gain(NSA_HEAD_DIM),
        "nsa_k_norm": gain(NSA_HEAD_DIM),
        "nsa_pe_k": nrm((L, CMP_BLOCK, NSA_HEAD_DIM), 0.5),
        "nsa_w1_k": nrm((L, cmp_in, CMP_HIDDEN), cmp_in ** -0.5),
        "nsa_w2_k": nrm((L, CMP_HIDDEN, NSA_HEAD_DIM), CMP_HIDDEN ** -0.5),
        "nsa_pe_v": nrm((L, CMP_BLOCK, NSA_HEAD_DIM), 0.5),
        "nsa_w1_v": nrm((L, cmp_in, CMP_HIDDEN), cmp_in ** -0.5),
        "nsa_w2_v": nrm((L, CMP_HIDDEN, NSA_HEAD_DIM), CMP_HIDDEN ** -0.5),
        "conv_dw_w": nrm((L, CONV_KERNEL, CONV_WIDTH), CONV_KERNEL ** -0.5),
        "conv_dw_b": nrm((L, CONV_WIDTH), 0.01),
        "conv_norm": gain(CONV_WIDTH),
        "w_branch": nrm((L, N_BRANCH, BRANCH_WIDTH, D_MODEL), BRANCH_WIDTH ** -0.5),
        "w_out": nrm((L, D_MODEL, D_MODEL), D_MODEL ** -0.5),
        "ffn2_norm": gain(D_MODEL),
        "ffn2_w_in": nrm((L, D_MODEL, 2 * FFN_DIM), D_MODEL ** -0.5),
        "ffn2_w_out": nrm((L, FFN_DIM, D_MODEL), FFN_DIM ** -0.5),
    }


def reference(x, ffn1_norm, ffn1_w_in, ffn1_w_out, mix_norm, w_in,
              sgu_v_norm, sgu_w, sgu_b,
              ssm_conv_w, ssm_conv_b, ssm_dt_bias, ssm_a_log, ssm_d, ssm_norm,
              nsa_q_norm, nsa_k_norm, nsa_pe_k, nsa_w1_k, nsa_w2_k, nsa_pe_v, nsa_w1_v, nsa_w2_v,
              conv_dw_w, conv_dw_b, conv_norm,
              w_branch, w_out, ffn2_norm, ffn2_w_in, ffn2_w_out):
    bsz, s, _ = x.shape
    split_at = [int(v) for v in np.cumsum(SPLIT_SIZES)[:-1]]
    for l in range(DEPTH):
        x = x + 0.5 * swiglu(rms_norm(x, ffn1_norm[l]), ffn1_w_in[l], ffn1_w_out[l])
        h = rms_norm(x, mix_norm[l])
        (a_uv, b_z, b_xbc, b_dt, c_q, c_kc, c_vc, c_ks, c_vs, c_kw, c_vw, c_gate,
         d_ab, merge_logits) = jnp.split(h @ w_in[l], split_at, axis=-1)
        y_a = sgu_mixer(a_uv, sgu_v_norm[l], sgu_w[l], sgu_b[l])
        y_b = mamba2_mixer(b_z, b_xbc, b_dt, ssm_conv_w[l], ssm_conv_b[l], ssm_dt_bias[l],
                           ssm_a_log[l], ssm_d[l], ssm_norm[l])
        y_c = nsa_mixer(c_q, c_kc, c_vc, c_ks, c_vs, c_kw, c_vw, c_gate, nsa_q_norm[l], nsa_k_norm[l],
                        nsa_pe_k[l], nsa_w1_k[l], nsa_w2_k[l], nsa_pe_v[l], nsa_w1_v[l], nsa_w2_v[l])
        y_d = conv_module(d_ab, conv_dw_w[l], conv_dw_b[l], conv_norm[l])
        ys = jnp.stack([y_a, y_b, y_c, y_d], axis=2)
        branch = jnp.einsum("bsie,ied->bsid", ys, w_branch[l])
        gates = jax.nn.sigmoid(merge_logits.reshape(bsz, s, N_BRANCH, D_MODEL))
        x = x + jnp.sum(gates * branch, axis=2) @ w_out[l]
        x = x + 0.5 * swiglu(rms_norm(x, ffn2_norm[l]), ffn2_w_in[l], ffn2_w_out[l])
    return x
```

```cpp
#include <hip/hip_runtime.h>
#include <hip/hip_cooperative_groups.h>
#include <cstdio>
namespace cg = cooperative_groups;

#define LAS __attribute__((address_space(3)))
typedef unsigned short bf16_t;
typedef short bf16x8 __attribute__((ext_vector_type(8)));
typedef float f32x4 __attribute__((ext_vector_type(4)));
typedef float f32x2 __attribute__((ext_vector_type(2)));
typedef unsigned u32x4 __attribute__((ext_vector_type(4)));
typedef unsigned u32x2 __attribute__((ext_vector_type(2)));
typedef LAS unsigned char* lptr;

#ifndef GEMM_ALIGN
#define GEMM_ALIGN true
#endif
#ifndef GEMM_SP2
#define GEMM_SP2 true
#endif
#ifndef PROBE_REP
#define PROBE_REP 1
#endif
#ifndef MIX_MASK
#define MIX_MASK 15
#endif

constexpr int NTOK = 16384, SEQ = 2048, DM = 1024, FF = 2816, NFF = 5632, PLD = 4896, NIN = 9216, NLAYER = 4;
constexpr int YLD = 2048;
constexpr int NT = 512;
constexpr int LDS_BYTES = 147456;
constexpr float EPS = 1e-6f;
constexpr int C_U = 0, C_V = 512, C_Z = 1024, C_XBC = 1536, C_Q = 2560, C_KC = 3072, C_VC = 3200, C_KS = 3328, C_VS = 3456, C_KW = 3584, C_VW = 3712,
              C_AB = 3840, C_DT = 4864, C_GATE = 4872;

constexpr size_t WS_W1IN = 0;
constexpr size_t WS_W1OUT = WS_W1IN + (size_t)NFF * DM * 2;
constexpr size_t WS_WIN = WS_W1OUT + (size_t)DM * FF * 2;
constexpr size_t WS_WB = WS_WIN + (size_t)NIN * DM * 2;
constexpr size_t WS_WO = WS_WB + (size_t)4096 * 512 * 2;
constexpr size_t WS_W2IN = WS_WO + (size_t)DM * DM * 2;
constexpr size_t WS_W2OUT = WS_W2IN + (size_t)NFF * DM * 2;
constexpr size_t WS_WC1K = WS_W2OUT + (size_t)DM * FF * 2;
constexpr size_t WS_WC1V = WS_WC1K + (size_t)128 * 2048 * 2;
constexpr size_t WS_WC2K = WS_WC1V + (size_t)128 * 2048 * 2;
constexpr size_t WS_WC2V = WS_WC2K + (size_t)64 * 128 * 2;
constexpr size_t WS_WEND = WS_WC2V + (size_t)64 * 128 * 2;
constexpr size_t WS_XN = 64ull << 20;
constexpr size_t WS_PROJ = WS_XN + (size_t)NTOK * DM * 2;
constexpr size_t WS_MERGED = WS_PROJ + (size_t)NTOK * DM * 4;
constexpr size_t WS_GATES = WS_PROJ + (size_t)NTOK * PLD * 2;
constexpr size_t WS_YS = WS_GATES + (size_t)NTOK * 4096 * 2;
constexpr size_t WS_STATES = WS_YS + (size_t)NTOK * YLD * 2;
constexpr size_t WS_ATOT = WS_STATES + (size_t)8 * 16 * 8 * 64 * 128 * 4;
constexpr size_t WS_KCMP = WS_ATOT + 4096;
constexpr size_t WS_VCMPT = WS_KCMP + (size_t)8 * 2 * 128 * 64 * 2;
constexpr size_t WS_SINB = WS_VCMPT + (size_t)8 * 2 * 128 * 64 * 2;
constexpr size_t WS_RSQ = WS_SINB + (size_t)8 * 16 * 8 * 8192 * 2;
constexpr size_t WS_BAR = WS_RSQ + 3 * 16 * 65536;
constexpr size_t WS_END = WS_BAR + 16384;
static_assert(WS_WEND <= WS_XN, "weights region");

struct Params {
    const float* in[31];
    float* out;
    unsigned char* ws;
};
enum { I_X = 0, I_F1N, I_F1WI, I_F1WO, I_MIXN, I_WIN, I_SGUVN, I_SGUW, I_SGUB, I_SCW, I_SCB, I_SDTB, I_SALOG, I_SD, I_SNORM, I_QN, I_KN, I_PEK, I_W1K, I_W2K,
       I_PEV, I_W1V, I_W2V, I_CDW, I_CDB, I_CNORM, I_WBR, I_WOUT, I_F2N, I_F2WI, I_F2WO };

__device__ __forceinline__ float bf2f(bf16_t b) { return __uint_as_float(((unsigned)b) << 16); }
__device__ __forceinline__ unsigned pk2(float lo, float hi) { unsigned r; asm("v_cvt_pk_bf16_f32 %0, %1, %2" : "=v"(r) : "v"(lo), "v"(hi)); return r; }
__device__ __forceinline__ bf16_t f2bf(float f) { return (bf16_t)(pk2(f, 0.f) & 0xffffu); }
__device__ __forceinline__ float lo16(unsigned w) { return __uint_as_float(w << 16); }
__device__ __forceinline__ float hi16(unsigned w) { return __uint_as_float(w & 0xffff0000u); }
__device__ __forceinline__ void unpack8(u32x4 v, float* f) { f[0] = lo16(v.x); f[1] = hi16(v.x); f[2] = lo16(v.y); f[3] = hi16(v.y); f[4] = lo16(v.z); f[5] = hi16(v.z); f[6] = lo16(v.w); f[7] = hi16(v.w); }
__device__ __forceinline__ u32x4 pack8(const float* f) { u32x4 o; o.x = pk2(f[0], f[1]); o.y = pk2(f[2], f[3]); o.z = pk2(f[4], f[5]); o.w = pk2(f[6], f[7]); return o; }
__device__ __forceinline__ float rcpf(float x) { return __builtin_amdgcn_rcpf(x); }
__device__ __forceinline__ float sigmoidf_(float x) { return rcpf(1.0f + __expf(-x)); }
__device__ __forceinline__ float siluf_(float x) { return x * sigmoidf_(x); }
__device__ __forceinline__ float gelu_tanh(float v) { const float u = 0.7978845608f * (v + 0.044715f * v * v * v); return v * rcpf(1.0f + __expf(-2.0f * u)); }
__device__ __forceinline__ float wave_sum(float v) {
#pragma unroll
    for (int o = 32; o >= 1; o >>= 1) v += __shfl_xor(v, o);
    return v;
}
__device__ __forceinline__ f32x4 MF(bf16x8 a, bf16x8 b, f32x4 c) { return __builtin_amdgcn_mfma_f32_16x16x32_bf16(a, b, c, 0, 0, 0); }
__device__ __forceinline__ bf16x8 ldfrag(lptr base, int off_elems) { return *(const LAS bf16x8*)(base + (size_t)off_elems * 2); }
__device__ __forceinline__ bf16x8 ldfrag2(lptr base, int off0, int off1) {
    const u32x2 a = *(const LAS u32x2*)(base + (size_t)off0 * 2), b = *(const LAS u32x2*)(base + (size_t)off1 * 2);
    u32x4 v; v.x = a.x; v.y = a.y; v.z = b.x; v.w = b.y; return __builtin_bit_cast(bf16x8, v);
}
typedef short s16x4 __attribute__((ext_vector_type(4)));
__device__ __forceinline__ bf16x8 ldfrag_tr(lptr base, int ld, int k0, int k1, int n0, int lane) {
    const int g = lane >> 4, q = (lane & 15) >> 2, pp = lane & 3;
    const LAS s16x4* a0 = (const LAS s16x4*)(base + (size_t)((k0 + 4 * g + q) * ld + n0 + 4 * pp) * 2);
    const LAS s16x4* a1 = (const LAS s16x4*)(base + (size_t)((k1 + 4 * g + q) * ld + n0 + 4 * pp) * 2);
    const s16x4 lo = __builtin_amdgcn_ds_read_tr16_b64_v4i16((LAS s16x4*)a0), hi = __builtin_amdgcn_ds_read_tr16_b64_v4i16((LAS s16x4*)a1);
    bf16x8 r; r[0] = lo[0]; r[1] = lo[1]; r[2] = lo[2]; r[3] = lo[3]; r[4] = hi[0]; r[5] = hi[1]; r[6] = hi[2]; r[7] = hi[3]; return r;
}
__device__ __forceinline__ bf16x8 packfrag(f32x4 t0, f32x4 t1) { u32x4 v; v.x = pk2(t0[0], t0[1]); v.y = pk2(t0[2], t0[3]); v.z = pk2(t1[0], t1[1]); v.w = pk2(t1[2], t1[3]); return __builtin_bit_cast(bf16x8, v); }
__device__ __forceinline__ void lds_st16(lptr p, bf16_t v) { *(LAS bf16_t*)p = v; }


#define XB_TMO      128
#define XB_XCNT(j)  (256  + 64 * (j))
#define XB_XSUB(j)  (1280 + 64 * (j))
#define XB_XGEN(j)  (2304 + 64 * (j))
#define XB_TOP      3328
#define XB_TOPGEN   3392
#define XCD_BAR_WORDS 3456
#define XB_SPIN_CAP (1u << 22)
__device__ __forceinline__ unsigned xb_ld(unsigned* p)              { return __hip_atomic_load(p, __ATOMIC_RELAXED, __HIP_MEMORY_SCOPE_AGENT); }
__device__ __forceinline__ unsigned xb_add(unsigned* p, unsigned v) { return __hip_atomic_fetch_add(p, v, __ATOMIC_RELAXED, __HIP_MEMORY_SCOPE_AGENT); }
__device__ __forceinline__ unsigned xb_xcc_id() { return (unsigned)__builtin_amdgcn_s_getreg((3 << 11) | 20) & 0xFu; }
#define XB_SPIN(cond, bar) do { unsigned _sp = 0; while (cond) { __builtin_amdgcn_s_sleep(1); \
    if ((++_sp & 255u) == 0u) { if (xb_ld(&(bar)[XB_TMO])) break; if (_sp > XB_SPIN_CAP) { atomicAdd(&(bar)[XB_TMO], 1u); break; } } } } while (0)
struct XcdBarrier { unsigned* bar; unsigned x; volatile LAS unsigned* st; };
__device__ __forceinline__ XcdBarrier xcd_barrier_post(unsigned* bar, volatile LAS unsigned* st) {
    XcdBarrier b; b.bar = bar; b.x = xb_xcc_id(); b.st = st;
    if (threadIdx.x == 0) (void)xb_add(&bar[XB_XCNT(b.x)], 1u);
    return b;
}
__device__ __forceinline__ void xcd_barrier_complete(unsigned* bar, unsigned x, unsigned& nloc, unsigned& nx) {
    const unsigned G = gridDim.x * gridDim.y * gridDim.z;
    unsigned sum, cnt, mine, sp = 0u;
    for (;;) {
        sum = 0u; cnt = 0u; mine = 0u;
#pragma unroll
        for (unsigned j = 0; j < 16; ++j) { const unsigned c = xb_ld(&bar[XB_XCNT(j)]); sum += c; cnt += (c > 0u) ? 1u : 0u; mine = (j == x) ? c : mine; }
        if (sum == G) break;
        __builtin_amdgcn_s_sleep(1);
        if ((++sp & 255u) == 0u) { if (xb_ld(&bar[XB_TMO])) break; if (sp > XB_SPIN_CAP) { atomicAdd(&bar[XB_TMO], 1u); break; } }
    }
    nloc = mine > 0u ? mine : 1u; nx = cnt > 0u ? cnt : 1u;
}
__device__ __forceinline__ void xcd_barrier(const XcdBarrier& b) {
    asm volatile("s_waitcnt vmcnt(0)" ::: "memory");
    __syncthreads();
    if (threadIdx.x == 0) {
        unsigned* bar = b.bar;
        __builtin_amdgcn_s_waitcnt(0);
        unsigned nloc = b.st[0], nx = b.st[1];
        if (nloc == 0u) { xcd_barrier_complete(bar, b.x, nloc, nx); b.st[0] = nloc; b.st[1] = nx; }
        const unsigned old = xb_add(&bar[XB_XSUB(b.x)], 1u);
        const unsigned gen = old / nloc;
        if (old + 1u == (gen + 1u) * nloc) {
            __builtin_amdgcn_fence(__ATOMIC_RELEASE, "agent");
            asm volatile("s_waitcnt vmcnt(0)" ::: "memory");
            const unsigned og = xb_add(&bar[XB_TOP], 1u);
            const unsigned tg = og / nx;
            if (og + 1u == (tg + 1u) * nx) xb_add(&bar[XB_TOPGEN], 1u);
            else XB_SPIN(xb_ld(&bar[XB_TOPGEN]) == tg, bar);
            __builtin_amdgcn_fence(__ATOMIC_ACQUIRE, "agent");
            xb_add(&bar[XB_XGEN(b.x)], 1u);
            asm volatile("s_waitcnt vmcnt(0)" ::: "memory");
        } else {
            XB_SPIN(xb_ld(&bar[XB_XGEN(b.x)]) == gen, bar);
            __builtin_amdgcn_fence(__ATOMIC_ACQUIRE, "agent");
            asm volatile("s_waitcnt vmcnt(0)" ::: "memory");
        }
    }
    __syncthreads();
}

namespace pg8 {
constexpr int BM = 256, BK = 64, HALF = 128, HTB = HALF * BK * 2, STAGE_BYTES = 8 * HTB, NXCD = 8, WGM = 8;
__device__ __forceinline__ int lds_byte(int r, int c) { const int st = (r >> 4) * 2 + (c >> 5), rr = r & 15, cc = c & 31, ob = rr * 64 + cc * 2; return st * 1024 + (ob ^ (((ob >> 9) & 1) << 5)); }
__device__ __forceinline__ void stage_rc(int b, int& R, int& C) { const int st = b / 1024, sb = b % 1024, swz = sb ^ (((sb >> 9) & 1) << 5); R = (st >> 1) * 16 + swz / 64; C = (st & 1) * 32 + (swz % 64) / 2; }
__device__ __forceinline__ int perm32(int rho) { const int n = rho >> 4, i = rho & 15; return 8 * (i >> 2) + 4 * n + (i & 3); }

struct Unit { int pm, pn, acol, ord; };
struct Gemm { const bf16_t* A; const bf16_t* Bt; int lda, K; };

struct StaticOrder {
    int nM, nN, nwg, G, c;
    __device__ void init(int M, int N, int G_, int c_) { nM = M / BM; nN = N / BM; nwg = nM * nN; G = G_; c = c_; }
    __device__ bool next(int i, Unit& u) const {
        const long L = (long)i * G + c; if (L >= nwg) return false;
        int wgid = (int)L; { const int q = nwg / NXCD, r = nwg % NXCD, xcd = wgid % NXCD, off = wgid / NXCD; wgid = (xcd < r ? xcd * (q + 1) : r * (q + 1) + (xcd - r) * q) + off; }
        const int nig = WGM * nN, gid = wgid / nig, fm = gid * WGM, gsz = (nM - fm) < WGM ? (nM - fm) : WGM;
        u.pm = fm + ((wgid % nig) % gsz); u.pn = (wgid % nig) / gsz; u.acol = 0; u.ord = i; return true;
    }
};
struct MergeOrder {
    StaticOrder so;
    __device__ void init(int G_, int c_) { so.init(NTOK, DM, G_, c_); }
    __device__ bool next(int i, Unit& u) const { Unit b; if (!so.next(i >> 2, b)) return false; const int sub = i & 3; u.pm = b.pm; u.pn = sub * 4 + b.pn; u.acol = sub * 512; u.ord = i; return true; }
};

template <class Epi, class Sched, bool ALIGN_EPI = GEMM_ALIGN, bool SP2 = GEMM_SP2>
__device__ __forceinline__ void gemm_phase(lptr lds, const Gemm g, const Sched& S, const Epi& E) {
    int tid_ = threadIdx.x; asm volatile("" : "+v"(tid_)); const int tid = tid_, wid = __builtin_amdgcn_readfirstlane(tid >> 6), lane = tid & 63, wr = wid >> 2, wc = wid & 3, fr = lane & 15, fq = lane >> 4;
    const int K = g.K, nt = K / BK, lda = g.lda;
    unsigned voffA[2], voffB[2];
#pragma unroll
    for (int i = 0; i < 2; ++i) { int R, C; stage_rc(tid * 16 + i * 8192, R, C); const int Rb = Epi::PERM ? ((R & ~31) + perm32(R & 31)) : R;
        voffA[i] = (unsigned)(R * lda + C) * 2u; voffB[i] = (unsigned)(Rb * K + C) * 2u; }
    const size_t kstep = (size_t)(BK * 2);
    const size_t hstepA = (size_t)HALF * lda * 2, tstepA = 2 * hstepA;
    const size_t hstepB = (size_t)HALF * K * 2, tstepB = 2 * hstepB;
    const unsigned ldsw = (unsigned)wid * 1024u;
    const int aoff = lds_byte(wr * 64 + fr, fq * 8), boff = lds_byte(wc * 32 + fr, fq * 8);
#define PG8_SA(b, h) (((b) * 2 + (h)) * HTB)
#define PG8_SB(b, h) ((4 + (b) * 2 + (h)) * HTB)
#define PG8_STAGE(bufoff, gbase, voff) do { _Pragma("unroll") for (int _i = 0; _i < 2; ++_i) \
        __builtin_amdgcn_global_load_lds((const unsigned*)((const char*)(gbase) + (voff)[_i]), (LAS unsigned*)(lds + (bufoff) + ldsw + _i * 8192), 16, 0, 0); } while (0)
#define PG8_LDA(dst, b, h) do { _Pragma("unroll") for (int m = 0; m < 4; ++m) _Pragma("unroll") for (int k = 0; k < 2; ++k) dst[m][k] = *(const LAS bf16x8*)(lds + PG8_SA(b, h) + aoff + m * 2048 + k * 1024); } while (0)
#define PG8_LDB(dst, b, h) do { _Pragma("unroll") for (int n = 0; n < 2; ++n) _Pragma("unroll") for (int k = 0; k < 2; ++k) dst[n][k] = *(const LAS bf16x8*)(lds + PG8_SB(b, h) + boff + n * 2048 + k * 1024); } while (0)
#define PG8_MMA(ai, bj, At, Bt) do { __builtin_amdgcn_s_setprio(1); _Pragma("unroll") for (int m = 0; m < 4; ++m) _Pragma("unroll") for (int n = 0; n < 2; ++n) _Pragma("unroll") for (int k = 0; k < 2; ++k) \
        acc[ai][bj][m][n] = __builtin_amdgcn_mfma_f32_16x16x32_bf16(Bt[n][k], At[m][k], acc[ai][bj][m][n], 0, 0, 0); __builtin_amdgcn_s_setprio(0); } while (0)
#define PG8_WAIT_V(n) asm volatile("s_waitcnt vmcnt(" #n ")" ::: "memory")
#define PG8_WAIT_L(n) asm volatile("s_waitcnt lgkmcnt(" #n ")" ::: "memory")
#define PG8_BAR __builtin_amdgcn_s_barrier()
#define PG8_SCHED __builtin_amdgcn_sched_barrier(0)
    Unit cur, nxt; int ui = 0;
    if (!S.next(0, cur)) return;
    f32x4 acc[2][2][4][2];
#pragma unroll
    for (int a = 0; a < 2; ++a)
#pragma unroll
        for (int b = 0; b < 2; ++b)
#pragma unroll
            for (int m = 0; m < 4; ++m)
#pragma unroll
                for (int n = 0; n < 2; ++n) acc[a][b][m][n] = (f32x4){0.f, 0.f, 0.f, 0.f};
    bf16x8 At[4][2], B0[2][2], B1[2][2];
    const char* cA = (const char*)g.A + (size_t)cur.pm * tstepA + (size_t)cur.acol * 2; const char* cB = (const char*)g.Bt + (size_t)cur.pn * tstepB;
    if constexpr (SP2) {
        PG8_STAGE(PG8_SB(0, 0), cB, voffB); PG8_STAGE(PG8_SB(0, 1), cB + hstepB, voffB); PG8_STAGE(PG8_SA(0, 0), cA, voffA); PG8_STAGE(PG8_SA(0, 1), cA + hstepA, voffA);
        if (wr == 1) PG8_BAR;
        PG8_WAIT_V(2); PG8_BAR;
        PG8_STAGE(PG8_SB(1, 0), cB + kstep, voffB); PG8_STAGE(PG8_SA(1, 0), cA + kstep, voffA); PG8_STAGE(PG8_SB(1, 1), cB + hstepB + kstep, voffB);
        PG8_WAIT_V(6); PG8_BAR;
    } else {
    PG8_STAGE(PG8_SB(0, 0), cB, voffB); PG8_STAGE(PG8_SA(0, 0), cA, voffA); PG8_STAGE(PG8_SB(0, 1), cB + hstepB, voffB); PG8_STAGE(PG8_SA(0, 1), cA + hstepA, voffA);
    if (wr == 1) PG8_BAR;
    PG8_WAIT_V(4); PG8_BAR;
    PG8_STAGE(PG8_SB(1, 0), cB + kstep, voffB); PG8_STAGE(PG8_SA(1, 0), cA + kstep, voffA); PG8_STAGE(PG8_SB(1, 1), cB + hstepB + kstep, voffB);
    PG8_WAIT_V(6); PG8_BAR;
    }
    for (;;) {
        const bool has_next = S.next(ui + 1, nxt);
        const char* nA = has_next ? (const char*)g.A + (size_t)nxt.pm * tstepA + (size_t)nxt.acol * 2 : cA; const char* nB = has_next ? (const char*)g.Bt + (size_t)nxt.pn * tstepB : cB;
        for (int t = 0; t < nt; t += 2) {
            const bool last = (t == nt - 2);
            const char* a1 = cA + (size_t)(t + 1) * kstep;
            const char* a2 = last ? nA : cA + (size_t)(t + 2) * kstep; const char* b2 = last ? nB : cB + (size_t)(t + 2) * kstep;
            const char* a3 = a2 + kstep; const char* b3 = b2 + kstep;
            if constexpr (SP2) {
            PG8_LDB(B0, 0, 0); PG8_LDB(B1, 0, 1); PG8_SCHED; PG8_LDA(At, 0, 0); PG8_STAGE(PG8_SA(1, 1), a1 + hstepA, voffA);
            PG8_WAIT_V(8); PG8_WAIT_L(0); PG8_BAR; PG8_MMA(0, 0, At, B0); PG8_MMA(0, 1, At, B1); PG8_BAR; PG8_SCHED;
            PG8_LDA(At, 0, 1); PG8_STAGE(PG8_SB(0, 0), b2, voffB); PG8_STAGE(PG8_SB(0, 1), b2 + hstepB, voffB); PG8_STAGE(PG8_SA(0, 0), a2, voffA);
            PG8_WAIT_V(8); PG8_WAIT_L(0); PG8_BAR; PG8_MMA(1, 0, At, B0); PG8_MMA(1, 1, At, B1); PG8_BAR; PG8_SCHED;
            PG8_LDB(B0, 1, 0); PG8_LDB(B1, 1, 1); PG8_SCHED; PG8_LDA(At, 1, 0); PG8_STAGE(PG8_SA(0, 1), a2 + hstepA, voffA);
            PG8_WAIT_V(8); PG8_WAIT_L(0); PG8_BAR; PG8_MMA(0, 0, At, B0); PG8_MMA(0, 1, At, B1); PG8_BAR; PG8_SCHED;
            PG8_LDA(At, 1, 1); PG8_STAGE(PG8_SB(1, 0), b3, voffB); PG8_STAGE(PG8_SB(1, 1), b3 + hstepB, voffB); PG8_STAGE(PG8_SA(1, 0), a3, voffA);
            PG8_WAIT_V(8); PG8_WAIT_L(0); PG8_BAR; PG8_MMA(1, 0, At, B0); PG8_MMA(1, 1, At, B1); PG8_BAR; PG8_SCHED;
            } else {
            PG8_LDB(B0, 0, 0); PG8_SCHED; PG8_LDA(At, 0, 0); PG8_STAGE(PG8_SA(1, 1), a1 + hstepA, voffA);
            PG8_WAIT_L(8); PG8_BAR; PG8_WAIT_L(0); PG8_MMA(0, 0, At, B0); PG8_BAR; PG8_SCHED;
            PG8_LDB(B1, 0, 1); PG8_STAGE(PG8_SB(0, 0), b2, voffB);
            PG8_BAR; PG8_WAIT_L(0); PG8_MMA(0, 1, At, B1); PG8_BAR;
            PG8_LDA(At, 0, 1); PG8_STAGE(PG8_SA(0, 0), a2, voffA);
            PG8_BAR; PG8_WAIT_L(0); PG8_MMA(1, 0, At, B0); PG8_BAR; PG8_SCHED;
            PG8_STAGE(PG8_SB(0, 1), b2 + hstepB, voffB);
            PG8_WAIT_V(6); PG8_BAR; PG8_MMA(1, 1, At, B1); PG8_BAR;
            PG8_LDB(B0, 1, 0); PG8_SCHED; PG8_LDA(At, 1, 0); PG8_STAGE(PG8_SA(0, 1), a2 + hstepA, voffA);
            PG8_WAIT_L(8); PG8_BAR; PG8_WAIT_L(0); PG8_MMA(0, 0, At, B0); PG8_BAR; PG8_SCHED;
            PG8_LDB(B1, 1, 1); PG8_STAGE(PG8_SB(1, 0), b3, voffB);
            PG8_BAR; PG8_WAIT_L(0); PG8_MMA(0, 1, At, B1); PG8_BAR;
            PG8_LDA(At, 1, 1); PG8_STAGE(PG8_SA(1, 0), a3, voffA);
            PG8_BAR; PG8_WAIT_L(0); PG8_MMA(1, 0, At, B0); PG8_BAR; PG8_SCHED;
            PG8_STAGE(PG8_SB(1, 1), b3 + hstepB, voffB);
            PG8_WAIT_V(6); PG8_BAR; PG8_MMA(1, 1, At, B1); PG8_BAR;
            }
        }
        if constexpr (ALIGN_EPI) { if (wr == 0) PG8_BAR; }
        bool zero_acc = true;
        if constexpr (Epi::CHAIN) zero_acc = E.chain(acc, cur, wr, wc, fr, fq); else E(acc, cur, wr, wc, fr, fq);
        if (!has_next) break;
        if (zero_acc)
#pragma unroll
        for (int a = 0; a < 2; ++a)
#pragma unroll
            for (int b = 0; b < 2; ++b)
#pragma unroll
                for (int m = 0; m < 4; ++m)
#pragma unroll
                    for (int n = 0; n < 2; ++n) acc[a][b][m][n] = (f32x4){0.f, 0.f, 0.f, 0.f};
        cur = nxt; cA = nA; cB = nB; ++ui;
        if constexpr (ALIGN_EPI) { if (wr == 1) PG8_BAR; }
    }
    PG8_WAIT_V(0);
    if constexpr (!ALIGN_EPI) { if (wr == 0) PG8_BAR; }
    PG8_BAR;
#undef PG8_SA
#undef PG8_SB
#undef PG8_STAGE
#undef PG8_LDA
#undef PG8_LDB
#undef PG8_MMA
#undef PG8_WAIT_V
#undef PG8_WAIT_L
#undef PG8_BAR
#undef PG8_SCHED
}

__device__ __forceinline__ float row_rstd(const float* rowsq, size_t row) {
    const f32x4* q = (const f32x4*)(rowsq + row * 16); const f32x4 a = q[0], b = q[1], c = q[2], d = q[3];
    const float s = ((a[0] + a[1]) + (a[2] + a[3])) + ((b[0] + b[1]) + (b[2] + b[3])) + ((c[0] + c[1]) + (c[2] + c[3])) + ((d[0] + d[1]) + (d[2] + d[3]));
    return rsqrtf(s * (1.f / DM) + EPS);
}
struct EpiResid {
    static constexpr bool PERM = false, CHAIN = false;
    const float* xin; float* out; float scale; bf16_t* xq; const float* gnext; float* rowsq;
    __device__ __forceinline__ void operator()(const f32x4 (&acc)[2][2][4][2], const Unit& u, int wr, int wc, int fr, int fq) const {
        const int row0 = u.pm * BM + wr * 64 + fr, col0 = u.pn * BM + wc * 32 + 4 * fq;
        f32x4 gv[2][2];
#pragma unroll
        for (int bj = 0; bj < 2; ++bj)
#pragma unroll
            for (int n = 0; n < 2; ++n) gv[bj][n] = *(const f32x4*)(gnext + col0 + bj * HALF + n * 16);
#pragma unroll
        for (int ai = 0; ai < 2; ++ai)
#pragma unroll
            for (int mp = 0; mp < 2; ++mp) { f32x4 xv[2][2][2];
#pragma unroll
                for (int mm = 0; mm < 2; ++mm)
#pragma unroll
                    for (int bj = 0; bj < 2; ++bj)
#pragma unroll
                        for (int n = 0; n < 2; ++n) xv[mm][bj][n] = *(const f32x4*)(xin + (size_t)(row0 + ai * HALF + (mp * 2 + mm) * 16) * DM + col0 + bj * HALF + n * 16);
#pragma unroll
                for (int mm = 0; mm < 2; ++mm) { const int m = mp * 2 + mm; const int row = row0 + ai * HALF + m * 16; const size_t off = (size_t)row * DM + col0; float ss = 0.f;
#pragma unroll
                    for (int bj = 0; bj < 2; ++bj)
#pragma unroll
                        for (int n = 0; n < 2; ++n) { const f32x4 v = xv[mm][bj][n] + acc[ai][bj][m][n] * scale; *(f32x4*)(out + off + bj * HALF + n * 16) = v;
                            if (xq) { ss += (v[0] * v[0] + v[1] * v[1]) + (v[2] * v[2] + v[3] * v[3]); const f32x4 q = v * gv[bj][n]; u32x2 w; w.x = pk2(q[0], q[1]); w.y = pk2(q[2], q[3]); *(u32x2*)(xq + off + bj * HALF + n * 16) = w; } }
                    if (xq) { ss += __shfl_xor(ss, 16); ss += __shfl_xor(ss, 32); if (fq == 0) rowsq[(size_t)row * 16 + u.pn * 4 + wc] = ss; } } }
    }
};
struct EpiSwiglu {
    static constexpr bool PERM = true, CHAIN = false;
    bf16_t* hid; const LAS float* rst;
    __device__ __forceinline__ void operator()(const f32x4 (&acc)[2][2][4][2], const Unit& u, int wr, int wc, int fr, int fq) const {
        const int row0 = u.pm * BM + wr * 64 + fr, col0 = u.pn * 128 + wc * 32 + 8 * fq;
        float rsv[2][4];
#pragma unroll
        for (int ai = 0; ai < 2; ++ai)
#pragma unroll
            for (int m = 0; m < 4; ++m) rsv[ai][m] = rst[u.ord * 256 + wr * 64 + fr + ai * HALF + m * 16];
#pragma unroll
        for (int ai = 0; ai < 2; ++ai)
#pragma unroll
            for (int m = 0; m < 4; ++m) { float o[8]; const float rs = rsv[ai][m];
#pragma unroll
                for (int n = 0; n < 2; ++n)
#pragma unroll
                    for (int j = 0; j < 4; ++j) o[n * 4 + j] = siluf_(acc[ai][0][m][n][j] * rs) * (acc[ai][1][m][n][j] * rs);
                *(u32x4*)(hid + (size_t)(row0 + ai * HALF + m * 16) * FF + col0) = pack8(o); }
    }
};
struct EpiInproj {
    static constexpr bool PERM = true, CHAIN = false;
    bf16_t* proj; unsigned char* gates; const LAS float* rst;
    __device__ __forceinline__ void operator()(const f32x4 (&acc)[2][2][4][2], const Unit& u, int wr, int wc, int fr, int fq) const {
        const int row0 = u.pm * BM + wr * 64 + fr;
        const int mode = u.pn < 4 ? 0 : (u.pn < 20 ? 1 : 2);
        float rsv[2][4];
#pragma unroll
        for (int ai = 0; ai < 2; ++ai)
#pragma unroll
            for (int m = 0; m < 4; ++m) rsv[ai][m] = rst[u.ord * 256 + wr * 64 + fr + ai * HALF + m * 16];
#pragma unroll
        for (int ai = 0; ai < 2; ++ai)
#pragma unroll
            for (int m = 0; m < 4; ++m) { const size_t row = (size_t)(row0 + ai * HALF + m * 16); const float rs = rsv[ai][m];
#pragma unroll
                for (int bj = 0; bj < 2; ++bj) { float o[8];
                    const int c0 = u.pn * BM + bj * HALF + wc * 32 + 8 * fq;
#pragma unroll
                    for (int n = 0; n < 2; ++n)
#pragma unroll
                        for (int j = 0; j < 4; ++j) { const float v = acc[ai][bj][m][n][j] * rs; o[n * 4 + j] = mode == 0 ? gelu_tanh(v) : (mode == 1 ? v : sigmoidf_(v)); }
                    if (mode == 2) { unsigned w0 = 0u, w1 = 0u;
#pragma unroll
                        for (int j = 0; j < 4; ++j) { w0 = __builtin_amdgcn_cvt_pk_u8_f32(fmaxf(o[j] * 255.f, 1.f), j, w0); w1 = __builtin_amdgcn_cvt_pk_u8_f32(fmaxf(o[4 + j] * 255.f, 1.f), j, w1); }
                        u32x2 wv; wv.x = w0; wv.y = w1; *(u32x2*)(gates + row * 4096 + (c0 - 5120)) = wv; }
                    else if (c0 < PLD) *(u32x4*)(proj + row * PLD + c0) = pack8(o); } }
    }
};
__device__ __forceinline__ void unpack_u8x8(u32x2 w, float* f) {
#pragma unroll
    for (int j = 0; j < 4; ++j) { f[j] = (float)((w.x >> (8 * j)) & 0xffu); f[4 + j] = (float)((w.y >> (8 * j)) & 0xffu); }
}
struct EpiMerge {
    static constexpr bool PERM = true, CHAIN = true;
    const unsigned char* gates; bf16_t* merged;
    __device__ __forceinline__ bool chain(f32x4 (&acc)[2][2][4][2], const Unit& u, int wr, int wc, int fr, int fq) const {
        const int row0 = u.pm * BM + wr * 64 + fr; const int bi = u.pn >> 2, nn = u.pn & 3; const bool lastb = bi == 3;
#pragma unroll
        for (int ai = 0; ai < 2; ++ai)
#pragma unroll
            for (int mp = 0; mp < 2; ++mp) { u32x2 g0[2][2], g1[2][2];
#pragma unroll
                for (int mm = 0; mm < 2; ++mm)
#pragma unroll
                    for (int bj = 0; bj < 2; ++bj) { const size_t row = (size_t)(row0 + ai * HALF + (mp * 2 + mm) * 16); const int c0 = nn * BM + bj * HALF + wc * 32 + 8 * fq;
                        g0[mm][bj] = *(const u32x2*)(gates + row * 4096 + bi * 1024 + c0);
                        g1[mm][bj] = lastb ? g0[mm][bj] : *(const u32x2*)(gates + row * 4096 + (bi + 1) * 1024 + c0); }
#pragma unroll
                for (int mm = 0; mm < 2; ++mm)
#pragma unroll
                    for (int bj = 0; bj < 2; ++bj) { const int m = mp * 2 + mm; const size_t row = (size_t)(row0 + ai * HALF + m * 16); const int c0 = nn * BM + bj * HALF + wc * 32 + 8 * fq; float ga[8], gb[8], o[8];
                        unpack_u8x8(g0[mm][bj], ga); unpack_u8x8(g1[mm][bj], gb);
#pragma unroll
                        for (int n = 0; n < 2; ++n)
#pragma unroll
                            for (int j = 0; j < 4; ++j) { const float f = lastb ? ga[n * 4 + j] * (1.f / 255.f) : ga[n * 4 + j] * rcpf(gb[n * 4 + j]); const float v = acc[ai][bj][m][n][j] * f; acc[ai][bj][m][n][j] = v; o[n * 4 + j] = v; }
                        if (lastb) *(u32x4*)(merged + row * DM + c0) = pack8(o); } }
        return lastb;
    }
};
}


template <class Sched> __device__ __forceinline__ void rstd_prologue(const Sched& S, const float* rowsq, LAS float* rst) {
    int t_ = threadIdx.x; asm volatile("" : "+v"(t_));
    pg8::Unit u;
    for (int i = 0; i < 12 && S.next(i, u); ++i) if (t_ < 256) rst[i * 256 + t_] = pg8::row_rstd(rowsq, (size_t)u.pm * 256 + t_);
    __syncthreads();
}

template <int MODE> __device__ __forceinline__ int srccol(int n) {
    if (MODE == 0) return n;
    if (MODE == 1) { const int tile = n >> 8, w = n & 255; return w < 128 ? tile * 128 + w : FF + tile * 128 + (w - 128); }
    if (n < 2560) return n;
    if (n < 3840) return n + 8;
    if (n < 4864) return n + 32;
    if (n < 4872) return n - 4864 + 2560;
    if (n < 4896) return n - 4872 + 3848;
    if (n < 5120) return -1;
    return n - 224;
}
template <int MODE>
__device__ __forceinline__ void transpose_item(const float* W, int K, int Nsrc, int Ndst, bf16_t* WT, LAS float* scr, int item, int lane) {
    const int nblk = Ndst / 32, kb = item / nblk, nb = item % nblk, k0 = 64 * kb, n0 = 32 * nb;
    const int sc = srccol<MODE>(n0 + (lane & 31));
#pragma unroll
    for (int i = 0; i < 32; ++i) { const int kk = 2 * i + (lane >> 5); scr[kk * 33 + (lane & 31)] = sc >= 0 ? W[(size_t)(k0 + kk) * Nsrc + sc] : 0.f; }
    asm volatile("s_waitcnt lgkmcnt(0)" ::: "memory");
    const int c = lane & 7;
#pragma unroll
    for (int j = 0; j < 4; ++j) { const int n = (lane >> 3) + 8 * j; const LAS float* s = scr + (8 * c) * 33 + n;
        u32x4 o; o.x = pk2(s[0 * 33], s[1 * 33]); o.y = pk2(s[2 * 33], s[3 * 33]); o.z = pk2(s[4 * 33], s[5 * 33]); o.w = pk2(s[6 * 33], s[7 * 33]);
        *(u32x4*)(WT + (size_t)(n0 + n) * K + k0 + 8 * c) = o; }
    asm volatile("s_waitcnt lgkmcnt(0)" ::: "memory");
}
constexpr int CV_I0 = 16 * 176, CV_I1 = 44 * 32, CV_I2 = 16 * 288, CV_I3 = 8 * 32, CV_I7 = 16 * 32, CV_I10 = 32 * 4, CV_I12 = 2 * 2;
constexpr int CV_NA = CV_I0 + CV_I1 + CV_I2 + 2 * CV_I10 + 2 * CV_I12;
constexpr int CV_NB = CV_I0 + CV_I1 + 4 * CV_I3 + CV_I7;
__device__ __forceinline__ void convert_item_A(const Params& p, int l, int r, LAS float* scr, int lane) {
    unsigned char* ws = p.ws;
    if (r < CV_I0) { transpose_item<1>(p.in[I_F1WI] + (size_t)l * DM * NFF, DM, NFF, NFF, (bf16_t*)(ws + WS_W1IN), scr, r, lane); return; } r -= CV_I0;
    if (r < CV_I2) { transpose_item<2>(p.in[I_WIN] + (size_t)l * DM * 8992, DM, 8992, NIN, (bf16_t*)(ws + WS_WIN), scr, r, lane); return; } r -= CV_I2;
    if (r < CV_I1) { transpose_item<0>(p.in[I_F1WO] + (size_t)l * FF * DM, FF, DM, DM, (bf16_t*)(ws + WS_W1OUT), scr, r, lane); return; } r -= CV_I1;
    if (r < CV_I10) { transpose_item<0>(p.in[I_W1K] + (size_t)l * 2048 * 128, 2048, 128, 128, (bf16_t*)(ws + WS_WC1K), scr, r, lane); return; } r -= CV_I10;
    if (r < CV_I10) { transpose_item<0>(p.in[I_W1V] + (size_t)l * 2048 * 128, 2048, 128, 128, (bf16_t*)(ws + WS_WC1V), scr, r, lane); return; } r -= CV_I10;
    if (r < CV_I12) { transpose_item<0>(p.in[I_W2K] + (size_t)l * 128 * 64, 128, 64, 64, (bf16_t*)(ws + WS_WC2K), scr, r, lane); return; } r -= CV_I12;
    transpose_item<0>(p.in[I_W2V] + (size_t)l * 128 * 64, 128, 64, 64, (bf16_t*)(ws + WS_WC2V), scr, r, lane);
}
__device__ __forceinline__ void convert_item_B(const Params& p, int l, int r, LAS float* scr, int lane) {
    unsigned char* ws = p.ws;
    if (r < CV_I0) { transpose_item<1>(p.in[I_F2WI] + (size_t)l * DM * NFF, DM, NFF, NFF, (bf16_t*)(ws + WS_W2IN), scr, r, lane); return; } r -= CV_I0;
    if (r < CV_I1) { transpose_item<0>(p.in[I_F2WO] + (size_t)l * FF * DM, FF, DM, DM, (bf16_t*)(ws + WS_W2OUT), scr, r, lane); return; } r -= CV_I1;
    if (r < 4 * CV_I3) { const int bi = r / CV_I3; transpose_item<0>(p.in[I_WBR] + ((size_t)l * 4 + bi) * 512 * DM, 512, DM, DM, (bf16_t*)(ws + WS_WB) + (size_t)bi * DM * 512, scr, r % CV_I3, lane); return; } r -= 4 * CV_I3;
    transpose_item<0>(p.in[I_WOUT] + (size_t)l * DM * DM, DM, DM, DM, (bf16_t*)(ws + WS_WO), scr, r, lane);
}
__device__ __forceinline__ void convert_phase(const Params& p, int l, lptr lds) {
    int tid_ = threadIdx.x; asm volatile("" : "+v"(tid_)); const int wave = tid_ >> 6, lane = tid_ & 63;
    LAS float* scr = (LAS float*)(lds + wave * 16384);
    const int gw = blockIdx.x * 8 + wave, NGW = gridDim.x * 8;
    for (int it = gw; it < CV_NA; it += NGW) convert_item_A(p, l, it, scr, lane);
}
__device__ __forceinline__ void convert_wg_item(const Params& p, int l, int r2, lptr lds) {
    int tid_ = threadIdx.x; asm volatile("" : "+v"(tid_)); const int wave = tid_ >> 6, lane = tid_ & 63;
    LAS float* scr = (LAS float*)(lds + wave * 16384);
    constexpr int NB_WG = (CV_NB + 31) / 32;
#pragma unroll 1
    for (int k = 0; k < 4; ++k) {
        if (r2 < NB_WG) { const int w = r2 * 32 + k * 8 + wave; if (w < CV_NB) convert_item_B(p, l, w, scr, lane); }
        else { const int w = (r2 - NB_WG) * 32 + k * 8 + wave; if (w < CV_NA) convert_item_A(p, l + 1, w, scr, lane); } }
    __syncthreads();
}
__device__ __forceinline__ void norm_phase(const float* x, const float* g, bf16_t* xn, float* rowsq) {
    int tid_ = threadIdx.x; asm volatile("" : "+v"(tid_)); const int wave = tid_ >> 6, lane = tid_ & 63;
    const int gw = blockIdx.x * 8 + wave, NGW = gridDim.x * 8;
    f32x4 gv[4];
#pragma unroll
    for (int j = 0; j < 4; ++j) gv[j] = *((const f32x4*)g + lane + 64 * j);
    for (int m = gw; m < NTOK; m += NGW) {
        const f32x4* xr = (const f32x4*)(x + (size_t)m * DM) + lane;
        f32x4 v[4]; float s = 0.f;
#pragma unroll
        for (int j = 0; j < 4; ++j) { v[j] = xr[64 * j]; s += (v[j].x * v[j].x + v[j].y * v[j].y) + (v[j].z * v[j].z + v[j].w * v[j].w); }
        s = wave_sum(s); if (lane < 16) rowsq[(size_t)m * 16 + lane] = lane == 0 ? s : 0.f;
        u32x2* o8 = (u32x2*)(xn + (size_t)m * DM) + lane;
#pragma unroll
        for (int j = 0; j < 4; ++j) { u32x2 w; w.x = pk2(v[j].x * gv[j].x, v[j].y * gv[j].y); w.y = pk2(v[j].z * gv[j].z, v[j].w * gv[j].w); o8[64 * j] = w; }
    }
}
__device__ __forceinline__ void zero_rows(float* r) { int t_ = threadIdx.x; asm volatile("" : "+v"(t_)); for (int i = blockIdx.x * NT + t_; i < NTOK; i += gridDim.x * NT) r[i] = 0.f; }

__device__ __forceinline__ void qknorm_pass(bf16_t* proj, const float* qn, const float* kn) {
    int tid_ = threadIdx.x; asm volatile("" : "+v"(tid_));
    for (int idx = blockIdx.x * NT + tid_; idx < NTOK * 12; idx += gridDim.x * NT) {
        const int tok = idx / 12, v = idx % 12;
        const int col = v < 8 ? C_Q + v * 64 : (v < 10 ? C_KS + (v - 8) * 64 : C_KW + (v - 10) * 64);
        const float* w = v < 8 ? qn : kn; const float sc = v < 8 ? 0.125f * 1.4426950408889634f : 1.0f;
        u32x4* ptr = (u32x4*)(proj + (size_t)tok * PLD + col);
        u32x4 raw[8]; float ss = 0.f;
#pragma unroll
        for (int j = 0; j < 8; ++j) { raw[j] = ptr[j]; float f[8]; unpack8(raw[j], f);
#pragma unroll
            for (int e = 0; e < 8; ++e) ss += f[e] * f[e]; }
        const float r = rsqrtf(ss * (1.f / 64.f) + EPS) * sc;
#pragma unroll
        for (int j = 0; j < 8; ++j) { float f[8]; unpack8(raw[j], f);
#pragma unroll
            for (int e = 0; e < 8; ++e) f[e] = f[e] * r * w[j * 8 + e];
            ptr[j] = pack8(f); }
    }
}

__device__ __forceinline__ void sgu_item(const Params& p, int l, int item, lptr lds) {
    int tid_ = threadIdx.x; asm volatile("" : "+v"(tid_)); const int tid = tid_, wave = __builtin_amdgcn_readfirstlane(tid >> 6), lane = tid & 63, fr = lane & 15, fq = lane >> 4;
    const bf16_t* proj = (const bf16_t*)(p.ws + WS_PROJ); bf16_t* ys = (bf16_t*)(p.ws + WS_YS);
    const size_t tok0 = (size_t)item * 128;
    LAS float* rstd = (LAS float*)lds; lptr Ws = lds + 1024, VT = lds + 1024 + 34816;
    const float* vn = p.in[I_SGUVN] + l * 512;
#pragma unroll 8
    for (int rr = 0; rr < 16; ++rr) { const int t = wave * 16 + rr; float f[8]; unpack8(*(const u32x4*)(proj + (tok0 + t) * PLD + C_V + lane * 8), f); float ss = 0.f;
#pragma unroll
        for (int e = 0; e < 8; ++e) ss += f[e] * f[e];
        ss = wave_sum(ss); if (lane == 0) rstd[t] = rsqrtf(ss * (1.f / 512.f) + EPS); }
    __syncthreads();
    for (int g = 0; g < 4; ++g) {
        { const int t = tid >> 2, s0 = (tid & 3) * 32; const float* wrow = p.in[I_SGUW] + (((size_t)l * 4 + g) * 128 + t) * 128 + s0;
#pragma unroll
          for (int j = 0; j < 4; ++j) { const f32x4 a = *(const f32x4*)(wrow + j * 8), b = *(const f32x4*)(wrow + j * 8 + 4); float f[8] = {a.x, a.y, a.z, a.w, b.x, b.y, b.z, b.w};
#pragma unroll
              for (int e = 0; e < 8; ++e) if (s0 + j * 8 + e > t) f[e] = 0.f;
              *(LAS u32x4*)(Ws + ((size_t)t * 136 + s0 + j * 8) * 2) = pack8(f); } }
        { const int s = tid >> 2, d0 = (tid & 3) * 32; const float rs = rstd[s];
#pragma unroll
          for (int j = 0; j < 4; ++j) { float f[8]; unpack8(*(const u32x4*)(proj + (tok0 + s) * PLD + C_V + g * 128 + d0 + j * 8), f);
#pragma unroll
              for (int e = 0; e < 8; ++e) f[e] = f[e] * rs * vn[g * 128 + d0 + j * 8 + e];
              *(LAS u32x4*)(VT + ((size_t)s * 144 + d0 + j * 8) * 2) = pack8(f); } }
        __syncthreads();
        u32x2 upre[8];
#pragma unroll
        for (int ni = 0; ni < 8; ++ni) upre[ni] = *(const u32x2*)(proj + (tok0 + wave * 16 + fr) * PLD + C_U + g * 128 + ni * 16 + fq * 4);
        f32x4 acc[8];
#pragma unroll
        for (int ni = 0; ni < 8; ++ni) acc[ni] = (f32x4){0.f, 0.f, 0.f, 0.f};
        const int nks = (wave >> 1) + 1;
        for (int ks = 0; ks < nks; ++ks) { const bf16x8 a = ldfrag2(Ws, (wave * 16 + fr) * 136 + ks * 32 + fq * 4, (wave * 16 + fr) * 136 + ks * 32 + 16 + fq * 4);
#pragma unroll
            for (int ni = 0; ni < 8; ++ni) { const bf16x8 b = ldfrag_tr(VT, 144, ks * 32, ks * 32 + 16, ni * 16, lane); acc[ni] = MF(b, a, acc[ni]); } }
        const int t = wave * 16 + fr; const float bias = p.in[I_SGUB][((size_t)l * 4 + g) * 128 + t];
#pragma unroll
        for (int ni = 0; ni < 8; ++ni) { const int d = g * 128 + ni * 16 + fq * 4; const u32x2 uu = upre[ni];
            u32x2 o; o.x = pk2(lo16(uu.x) * (acc[ni][0] + bias), hi16(uu.x) * (acc[ni][1] + bias)); o.y = pk2(lo16(uu.y) * (acc[ni][2] + bias), hi16(uu.y) * (acc[ni][3] + bias));
            *(u32x2*)(ys + (tok0 + t) * YLD + d) = o; }
        __syncthreads();
    }
}

__device__ __forceinline__ float dt_acs_wave(const bf16_t* proj, size_t tokbase, int h, float dtb, float A, LAS float* dtv, LAS float* acs, int lane) {
    float d[2], a[2];
#pragma unroll
    for (int i = 0; i < 2; ++i) { const float raw = bf2f(proj[(tokbase + 2 * lane + i) * PLD + C_DT + h]) + dtb;
        const float sp = raw > 0.f ? raw + log1pf(__expf(-raw)) : log1pf(__expf(raw)); d[i] = sp; a[i] = sp * A; }
    float s = a[0] + a[1];
#pragma unroll
    for (int o = 1; o < 64; o <<= 1) { const float t = __shfl_up(s, o); if (lane >= o) s += t; }
    dtv[2 * lane] = d[0]; dtv[2 * lane + 1] = d[1]; acs[2 * lane] = s - a[1]; acs[2 * lane + 1] = s;
    return s;
}
struct Conv8 { float w[4][8]; float bias[8]; };
__device__ __forceinline__ void conv8_load(Conv8& c, const float* cw, const float* cb, int ch0) {
#pragma unroll
    for (int k = 0; k < 4; ++k) { const f32x4 a = *(const f32x4*)(cw + k * 1024 + ch0), b = *(const f32x4*)(cw + k * 1024 + ch0 + 4);
        c.w[k][0] = a.x; c.w[k][1] = a.y; c.w[k][2] = a.z; c.w[k][3] = a.w; c.w[k][4] = b.x; c.w[k][5] = b.y; c.w[k][6] = b.z; c.w[k][7] = b.w; }
    const f32x4 a = *(const f32x4*)(cb + ch0), b = *(const f32x4*)(cb + ch0 + 4);
    c.bias[0] = a.x; c.bias[1] = a.y; c.bias[2] = a.z; c.bias[3] = a.w; c.bias[4] = b.x; c.bias[5] = b.y; c.bias[6] = b.z; c.bias[7] = b.w;
}
__device__ __forceinline__ void ldrow8(const bf16_t* projb, int sp, int col, float* f) {
    if (sp < 0) {
#pragma unroll
        for (int e = 0; e < 8; ++e) f[e] = 0.f;
    } else unpack8(*(const u32x4*)(projb + (size_t)sp * PLD + col), f);
}
#define CONV_STEP(cv, x, y) do { _Pragma("unroll") for (int e_ = 0; e_ < 8; ++e_) { \
        const float v_ = cv.bias[e_] + cv.w[0][e_] * x[0][e_] + cv.w[1][e_] * x[1][e_] + cv.w[2][e_] * x[2][e_] + cv.w[3][e_] * x[3][e_]; y[e_] = siluf_(v_); \
        x[0][e_] = x[1][e_]; x[1][e_] = x[2][e_]; x[2][e_] = x[3][e_]; } } while (0)


template <int NTK, class F>
__device__ __forceinline__ void conv_run(const Conv8& cv, const bf16_t* projb, int sp0, int col, F&& f) {
    u32x4 raw[NTK + 3];
#pragma unroll
    for (int i = 0; i < NTK + 3; ++i) { const int sp = sp0 - 3 + i; raw[i] = sp >= 0 ? *(const u32x4*)(projb + (size_t)sp * PLD + col) : (u32x4){0u, 0u, 0u, 0u}; }
    float x[4][8];
    unpack8(raw[0], x[0]); unpack8(raw[1], x[1]); unpack8(raw[2], x[2]);
#pragma unroll
    for (int i = 0; i < NTK; ++i) { unpack8(raw[i + 3], x[3]); float y[8]; CONV_STEP(cv, x, y); f(i, y); }
}

__device__ __forceinline__ void mamba1_item(const Params& p, int l, int item, lptr lds) {
    int tid_ = threadIdx.x; asm volatile("" : "+v"(tid_)); const int tid = tid_, wave = __builtin_amdgcn_readfirstlane(tid >> 6), lane = tid & 63, fr = lane & 15, fq = lane >> 4;
    const int g = item & 1, c = (item >> 1) & 15, b = item >> 5;
    if (c == 15) return;
    const bf16_t* proj = (const bf16_t*)(p.ws + WS_PROJ); const bf16_t* projb = proj + (size_t)b * SEQ * PLD;
    LAS float* dtv = (LAS float*)lds; LAS float* acs = (LAS float*)(lds + 2048); lptr BT = lds + 4096, XdT = lds + 4096 + 36864;
    float* states = (float*)(p.ws + WS_STATES); float* atot = (float*)(p.ws + WS_ATOT);
    if (wave < 4) { const int h = g * 4 + wave; const float A = -__expf(p.in[I_SALOG][l * 8 + h]);
        const float tot = dt_acs_wave(proj, (size_t)b * SEQ + c * 128, h, p.in[I_SDTB][l * 8 + h], A, dtv + wave * 128, acs + wave * 128, lane);
        if (lane == 63) atot[(b * 16 + c) * 8 + h] = tot; }
    __syncthreads();
    if (tid < 384) { const int cgp = tid % 48, seg = tid / 48; const bool isB = cgp < 16; const int j = isB ? 0 : cgp - 16;
        const int ch0 = isB ? 512 + g * 128 + cgp * 8 : g * 256 + j * 8; const int hl = j >> 3, p0 = (j & 7) * 8;
        Conv8 cv; conv8_load(cv, p.in[I_SCW] + (size_t)l * 4096, p.in[I_SCB] + (size_t)l * 1024, ch0);
        const float aend = acs[hl * 128 + 127];
#pragma unroll 1
        for (int hf = 0; hf < 2; ++hf) { const int tb = seg * 16 + hf * 8;
            conv_run<8>(cv, projb, c * 128 + tb, C_XBC + ch0, [&](int i, const float* y) { const int tl = tb + i;
                const float sc = isB ? 1.f : dtv[hl * 128 + tl] * __expf(aend - acs[hl * 128 + tl]); float ys_[8];
#pragma unroll
                for (int e = 0; e < 8; ++e) ys_[e] = y[e] * sc;
                lptr dst = isB ? BT + ((size_t)tl * 144 + cgp * 8) * 2 : XdT + ((size_t)tl * 272 + hl * 64 + p0) * 2; *(LAS u32x4*)dst = pack8(ys_); }); }
    }
    __syncthreads();
    { const int hl = wave >> 1, pib = (wave & 1) * 2; f32x4 acc[2][8];
#pragma unroll
      for (int i = 0; i < 2; ++i)
#pragma unroll
          for (int ni = 0; ni < 8; ++ni) acc[i][ni] = (f32x4){0.f, 0.f, 0.f, 0.f};
#pragma unroll
      for (int ks = 0; ks < 4; ++ks) { bf16x8 a[2];
#pragma unroll
          for (int i = 0; i < 2; ++i) a[i] = ldfrag_tr(XdT, 272, ks * 32, ks * 32 + 16, hl * 64 + (pib + i) * 16, lane);
#pragma unroll
          for (int ni = 0; ni < 8; ++ni) { const bf16x8 bb = ldfrag_tr(BT, 144, ks * 32, ks * 32 + 16, ni * 16, lane);
#pragma unroll
              for (int i = 0; i < 2; ++i) acc[i][ni] = MF(bb, a[i], acc[i][ni]); } }
      float* st = states + (size_t)((b * 16 + c) * 8 + g * 4 + hl) * 8192;
#pragma unroll
      for (int i = 0; i < 2; ++i)
#pragma unroll
          for (int ni = 0; ni < 8; ++ni) *(f32x4*)(st + ((pib + i) * 16 + fr) * 128 + ni * 16 + fq * 4) = acc[i][ni];
    }
    __syncthreads();
}


__device__ __forceinline__ void prefix_phase(const Params& p) {
    int tid_ = threadIdx.x; asm volatile("" : "+v"(tid_));
    const float* states = (const float*)(p.ws + WS_STATES); const float* atot = (const float*)(p.ws + WS_ATOT); bf16_t* sinb = (bf16_t*)(p.ws + WS_SINB);
    for (int idx = blockIdx.x * NT + tid_; idx < 64 * 2048; idx += gridDim.x * NT) {
        const int bh = idx >> 11, e4 = (idx & 2047) * 4, b = bh >> 3, h = bh & 7;
        f32x4 st[15]; float dec[15];
#pragma unroll
        for (int c = 0; c < 15; ++c) { st[c] = *(const f32x4*)(states + (size_t)((b * 16 + c) * 8 + h) * 8192 + e4); dec[c] = atot[(b * 16 + c) * 8 + h]; }
        f32x4 S = (f32x4){0.f, 0.f, 0.f, 0.f};
#pragma unroll
        for (int c = 0; c < 15; ++c) { S = S * __expf(dec[c]) + st[c]; u32x2 o; o.x = pk2(S[0], S[1]); o.y = pk2(S[2], S[3]);
            *(u32x2*)(sinb + (size_t)((b * 16 + c + 1) * 8 + h) * 8192 + e4) = o; }
    }
}

__device__ __forceinline__ void mamba2_item(const Params& p, int l, int item, lptr lds) {
    int tid_ = threadIdx.x; asm volatile("" : "+v"(tid_)); const int tid = tid_, wave = __builtin_amdgcn_readfirstlane(tid >> 6), lane = tid & 63, fr = lane & 15, fq = lane >> 4;
    const int c = item & 15, b = item >> 4;
    const bf16_t* proj = (const bf16_t*)(p.ws + WS_PROJ); const bf16_t* projb = proj + (size_t)b * SEQ * PLD; bf16_t* ys = (bf16_t*)(p.ws + WS_YS);
    const bf16_t* sinb = (const bf16_t*)(p.ws + WS_SINB);
    LAS float* dtv = (LAS float*)lds; LAS float* acs = (LAS float*)(lds + 4096);
    lptr Cs = lds + 8192, Bs = lds + 43008, XT = lds + 77824, Sin = lds + 96256, XN = lds + 113664;
    const size_t tokbase = (size_t)b * SEQ + c * 128;
    { const int h = wave; const float A = -__expf(p.in[I_SALOG][l * 8 + h]); dt_acs_wave(proj, tokbase, h, p.in[I_SDTB][l * 8 + h], A, dtv + h * 128, acs + h * 128, lane); }
    __syncthreads();
    const int l_row = wave * 16 + fr;
    float ssq = 0.f;
#pragma unroll 1
    for (int g = 0; g < 2; ++g) {
        { const int cgp = tid & 31, seg = tid >> 5; const int ch0 = cgp < 16 ? 512 + g * 128 + cgp * 8 : 768 + g * 128 + (cgp - 16) * 8;
          lptr dst = cgp < 16 ? Bs : Cs; const int n0 = (cgp & 15) * 8;
          Conv8 cv; conv8_load(cv, p.in[I_SCW] + (size_t)l * 4096, p.in[I_SCB] + (size_t)l * 1024, ch0);
          conv_run<8>(cv, projb, c * 128 + seg * 8, C_XBC + ch0, [&](int i, const float* y) { *(LAS u32x4*)(dst + ((size_t)(seg * 8 + i) * 136 + n0) * 2) = pack8(y); }); }
        __syncthreads();
#pragma unroll 1
        for (int hl = 0; hl < 4; ++hl) { const int h = g * 4 + hl;
            u32x2 zpre[4];
#pragma unroll
            for (int pi = 0; pi < 4; ++pi) zpre[pi] = *(const u32x2*)(proj + (tokbase + l_row) * PLD + C_Z + h * 64 + pi * 16 + fq * 4);
            if (tid < 256) { const int cgp = tid & 7, seg = tid >> 3; const int ch0 = h * 64 + cgp * 8;
                Conv8 cv; conv8_load(cv, p.in[I_SCW] + (size_t)l * 4096, p.in[I_SCB] + (size_t)l * 1024, ch0);
                conv_run<4>(cv, projb, c * 128 + seg * 4, C_XBC + ch0, [&](int i, const float* y) { const int tl = seg * 4 + i;
                    *(LAS u32x4*)(XN + ((size_t)tl * 72 + cgp * 8) * 2) = pack8(y); const float d = dtv[h * 128 + tl]; float yd[8];
#pragma unroll
                    for (int e = 0; e < 8; ++e) yd[e] = y[e] * d;
                    *(LAS u32x4*)(XT + ((size_t)tl * 72 + cgp * 8) * 2) = pack8(yd); }); }
            if (c > 0) { const bf16_t* sb = sinb + (size_t)((b * 16 + c) * 8 + h) * 8192;
#pragma unroll
                for (int k = 0; k < 2; ++k) { const int idx = tid * 8 + k * 4096, pp = idx >> 7, n = idx & 127; *(LAS u32x4*)(Sin + ((size_t)pp * 136 + n) * 2) = *(const u32x4*)(sb + idx); } }
            __syncthreads();
            f32x4 y[4];
#pragma unroll
            for (int pi = 0; pi < 4; ++pi) y[pi] = (f32x4){0.f, 0.f, 0.f, 0.f};
            const float al = acs[h * 128 + l_row];
            bf16x8 aC[4];
#pragma unroll
            for (int ks = 0; ks < 4; ++ks) aC[ks] = ldfrag(Cs, (wave * 16 + fr) * 136 + ks * 32 + fq * 8);
            if (c > 0) {
#pragma unroll
                for (int ks = 0; ks < 4; ++ks) {
#pragma unroll
                    for (int pi = 0; pi < 4; ++pi) { const bf16x8 bb = ldfrag(Sin, (pi * 16 + fr) * 136 + ks * 32 + fq * 8); y[pi] = MF(bb, aC[ks], y[pi]); } }
                const float ea = __expf(al);
#pragma unroll
                for (int pi = 0; pi < 4; ++pi) y[pi] *= ea; }
#pragma unroll 1
            for (int ks2 = 0; 2 * ks2 <= wave; ++ks2) {
                f32x4 cb0 = (f32x4){0.f, 0.f, 0.f, 0.f}, cb1 = (f32x4){0.f, 0.f, 0.f, 0.f};
#pragma unroll
                for (int ks = 0; ks < 4; ++ks) { const bf16x8 b0 = ldfrag(Bs, ((2 * ks2) * 16 + fr) * 136 + ks * 32 + fq * 8), b1 = ldfrag(Bs, ((2 * ks2 + 1) * 16 + fr) * 136 + ks * 32 + fq * 8);
                    cb0 = MF(b0, aC[ks], cb0); cb1 = MF(b1, aC[ks], cb1); }
                const f32x4 a0 = *(const LAS f32x4*)(acs + h * 128 + (2 * ks2) * 16 + fq * 4), a1 = *(const LAS f32x4*)(acs + h * 128 + (2 * ks2 + 1) * 16 + fq * 4);
                f32x4 t0, t1;
#pragma unroll
                for (int j = 0; j < 4; ++j) { const int s0 = (2 * ks2) * 16 + fq * 4 + j, s1 = s0 + 16;
                    t0[j] = s0 <= l_row ? cb0[j] * __expf(fminf(al - a0[j], 0.f)) : 0.f;
                    t1[j] = s1 <= l_row ? cb1[j] * __expf(fminf(al - a1[j], 0.f)) : 0.f; }
                const bf16x8 pa = packfrag(t0, t1);
#pragma unroll
                for (int pi = 0; pi < 4; ++pi) { const bf16x8 bb = ldfrag_tr(XT, 72, (2 * ks2) * 16, (2 * ks2 + 1) * 16, pi * 16, lane); y[pi] = MF(bb, pa, y[pi]); } }
            const float Dh = p.in[I_SD][l * 8 + h];
#pragma unroll
            for (int pi = 0; pi < 4; ++pi) { const int pc = pi * 16 + fq * 4; const u32x2 xr = *(const LAS u32x2*)(XN + ((size_t)l_row * 72 + pc) * 2);
                const u32x2 zr = zpre[pi];
                const float xs4[4] = {lo16(xr.x), hi16(xr.x), lo16(xr.y), hi16(xr.y)}, z4[4] = {lo16(zr.x), hi16(zr.x), lo16(zr.y), hi16(zr.y)}; float o[4];
#pragma unroll
                for (int j = 0; j < 4; ++j) { o[j] = (y[pi][j] + xs4[j] * Dh) * siluf_(z4[j]); ssq += o[j] * o[j]; }
                u32x2 ov; ov.x = pk2(o[0], o[1]); ov.y = pk2(o[2], o[3]);
                *(u32x2*)(ys + (tokbase + l_row) * YLD + 512 + h * 64 + pc) = ov; }
            __syncthreads();
        }
    }
    ssq += __shfl_xor(ssq, 16); ssq += __shfl_xor(ssq, 32);
    const float rs = rsqrtf(ssq * (1.f / 512.f) + EPS);
    const float* ng = p.in[I_SNORM] + l * 512;
#pragma unroll 1
    for (int h = 0; h < 8; ++h)
#pragma unroll
        for (int pi = 0; pi < 4; ++pi) { const int col = h * 64 + pi * 16 + fq * 4; u32x2* ptr = (u32x2*)(ys + (tokbase + l_row) * YLD + 512 + col); const u32x2 r = *ptr; const f32x4 gg = *(const f32x4*)(ng + col);
            u32x2 ov; ov.x = pk2(lo16(r.x) * rs * gg.x, hi16(r.x) * rs * gg.y); ov.y = pk2(lo16(r.y) * rs * gg.z, hi16(r.y) * rs * gg.w); *ptr = ov; }
    __syncthreads();
}

__device__ __forceinline__ void compress_item(const Params& p, int l, int item, lptr lds) {
    int tid_ = threadIdx.x; asm volatile("" : "+v"(tid_)); const int tid = tid_, wave = __builtin_amdgcn_readfirstlane(tid >> 6), lane = tid & 63, fr = lane & 15, fq = lane >> 4;
    const int kv = item & 1, half = (item >> 1) & 1, g = (item >> 2) & 1, b = item >> 3;
    const bf16_t* projb = (const bf16_t*)(p.ws + WS_PROJ) + (size_t)b * SEQ * PLD;
    const int col = (kv ? C_VC : C_KC) + g * 64;
    const float* pe = p.in[kv ? I_PEV : I_PEK] + (size_t)l * 2048;
    const bf16_t* w1t = (const bf16_t*)(p.ws + (kv ? WS_WC1V : WS_WC1K)); const bf16_t* w2t = (const bf16_t*)(p.ws + (kv ? WS_WC2V : WS_WC2K));
    bf16_t* kcmp = (bf16_t*)(p.ws + WS_KCMP); bf16_t* vcmpT = (bf16_t*)(p.ws + WS_VCMPT);
    lptr As = lds, Bs = lds + 33792, H1 = lds + 101376, W2s = lds + 118784; LAS float* Of = (LAS float*)lds;
    const int mi = wave >> 1, nib = (wave & 1) * 4;
    f32x4 acc[4];
#pragma unroll
    for (int i = 0; i < 4; ++i) acc[i] = (f32x4){0.f, 0.f, 0.f, 0.f};
    for (int step = 0; step < 8; ++step) {
        { const int r = tid >> 3, q = tid & 7, pp = q >> 1, e0 = (q & 1) * 32; const int cmp = half * 64 + r, pos = 16 * cmp + step * 4 + pp;
#pragma unroll
          for (int j = 0; j < 4; ++j) { float f[8];
              if (pos < SEQ) unpack8(*(const u32x4*)(projb + (size_t)pos * PLD + col + e0 + j * 8), f); else {
#pragma unroll
                  for (int e = 0; e < 8; ++e) f[e] = 0.f; }
              const float* pr = pe + (step * 4 + pp) * 64 + e0 + j * 8;
#pragma unroll
              for (int e = 0; e < 8; ++e) f[e] += pr[e];
              *(LAS u32x4*)(As + ((size_t)r * 264 + pp * 64 + e0 + j * 8) * 2) = pack8(f); } }
        { const int jrow = tid >> 2, k0 = (tid & 3) * 64;
#pragma unroll
          for (int j = 0; j < 8; ++j) *(LAS u32x4*)(Bs + ((size_t)jrow * 264 + k0 + j * 8) * 2) = *(const u32x4*)(w1t + (size_t)jrow * 2048 + step * 256 + k0 + j * 8); }
        __syncthreads();
#pragma unroll
        for (int ks = 0; ks < 8; ++ks) { const bf16x8 a = ldfrag(As, (mi * 16 + fr) * 264 + ks * 32 + fq * 8);
#pragma unroll
            for (int i = 0; i < 4; ++i) { const bf16x8 bb = ldfrag(Bs, ((nib + i) * 16 + fr) * 264 + ks * 32 + fq * 8); acc[i] = MF(bb, a, acc[i]); } }
        __syncthreads();
    }
#pragma unroll
    for (int i = 0; i < 4; ++i) { const int r = mi * 16 + fr, j0 = (nib + i) * 16 + fq * 4; u32x2 o; o.x = pk2(gelu_tanh(acc[i][0]), gelu_tanh(acc[i][1])); o.y = pk2(gelu_tanh(acc[i][2]), gelu_tanh(acc[i][3]));
        *(LAS u32x2*)(H1 + ((size_t)r * 136 + j0) * 2) = o; }
    { const int e = tid >> 3, k0 = (tid & 7) * 16;
#pragma unroll
      for (int j = 0; j < 2; ++j) *(LAS u32x4*)(W2s + ((size_t)e * 136 + k0 + j * 8) * 2) = *(const u32x4*)(w2t + e * 128 + k0 + j * 8); }
    __syncthreads();
    { const int eib = (wave & 1) * 2; f32x4 a2[2] = {(f32x4){0.f, 0.f, 0.f, 0.f}, (f32x4){0.f, 0.f, 0.f, 0.f}};
#pragma unroll
      for (int ks = 0; ks < 4; ++ks) { const bf16x8 a = ldfrag(H1, (mi * 16 + fr) * 136 + ks * 32 + fq * 8);
#pragma unroll
          for (int i = 0; i < 2; ++i) { const bf16x8 bb = ldfrag(W2s, ((eib + i) * 16 + fr) * 136 + ks * 32 + fq * 8); a2[i] = MF(bb, a, a2[i]); } }
#pragma unroll
      for (int i = 0; i < 2; ++i)
#pragma unroll
          for (int j = 0; j < 4; ++j) Of[(mi * 16 + fr) * 65 + (eib + i) * 16 + fq * 4 + j] = a2[i][j]; }
    __syncthreads();
    { const int r = tid >> 3, e0 = (tid & 7) * 8; const int cmp = half * 64 + r; float f[8]; float ss = 0.f;
#pragma unroll
      for (int e = 0; e < 8; ++e) { f[e] = Of[r * 65 + e0 + e]; ss += f[e] * f[e]; }
      ss += __shfl_xor(ss, 1); ss += __shfl_xor(ss, 2); ss += __shfl_xor(ss, 4);
      if (kv == 0) { const float rs = rsqrtf(ss * (1.f / 64.f) + EPS); const float* kn = p.in[I_KN] + l * 64;
#pragma unroll
          for (int e = 0; e < 8; ++e) f[e] = cmp == 127 ? 0.f : f[e] * rs * kn[e0 + e];
          *(u32x4*)(kcmp + ((size_t)(b * 2 + g) * 128 + cmp) * 64 + e0) = pack8(f); }
      else {
#pragma unroll
          for (int e = 0; e < 8; ++e) vcmpT[((size_t)(b * 2 + g) * 64 + e0 + e) * 128 + cmp] = cmp == 127 ? (bf16_t)0 : f2bf(f[e]); } }
    __syncthreads();
}

template <int KIND>
__device__ __forceinline__ void attn_tile(lptr Ks, lptr VT, lptr Qs, int qrow, const int (&trow)[2], float slope, int j, bool masked, const LAS unsigned* selq,
                                          float (&m)[2], float (&lsum)[2], f32x4 (&O)[2][4], int fr, int fq) {
    f32x4 S[2][4];
    { f32x4 cb0;
#pragma unroll
      for (int jj = 0; jj < 4; ++jj) cb0[jj] = slope * (float)(fq * 4 + jj);
#pragma unroll
      for (int ni = 0; ni < 4; ++ni) { S[0][ni] = cb0 + slope * (float)(64 * j + 16 * ni); S[1][ni] = S[0][ni]; } }
    unsigned selrow[2] = {0u, 0u};
    if (KIND == 1) { selrow[0] = selq[fr]; selrow[1] = selq[16 + fr]; }
#pragma unroll
    for (int ks = 0; ks < 2; ++ks)
    { const bf16x8 q0 = ldfrag(Qs, (qrow + fr) * 72 + ks * 32 + fq * 8), q1 = ldfrag(Qs, (qrow + 16 + fr) * 72 + ks * 32 + fq * 8);
#pragma unroll
        for (int ni = 0; ni < 4; ++ni) { const bf16x8 kf = ldfrag(Ks, (ni * 16 + fr) * 72 + ks * 32 + fq * 8); S[0][ni] = MF(kf, q0, S[0][ni]); S[1][ni] = MF(kf, q1, S[1][ni]); } }
    if (masked) {
#pragma unroll
        for (int mi = 0; mi < 2; ++mi) { const bool rowsel = KIND == 1 ? (((selrow[mi] >> j) & 1u) != 0u) : true;
            const int tl = rowsel ? trow[mi] - 64 * j - fq * 4 : -1;
#pragma unroll
            for (int ni = 0; ni < 4; ++ni)
#pragma unroll
                for (int jj = 0; jj < 4; ++jj) { const bool valid = KIND == 1 ? (ni * 16 + jj <= tl) : ((unsigned)(tl - (ni * 16 + jj)) < 256u); S[mi][ni][jj] = valid ? S[mi][ni][jj] : -1e30f; } }
    } else if (KIND == 1) {
#pragma unroll
        for (int mi = 0; mi < 2; ++mi) { const bool rowsel = ((selrow[mi] >> j) & 1u) != 0u;
#pragma unroll
            for (int ni = 0; ni < 4; ++ni)
#pragma unroll
                for (int jj = 0; jj < 4; ++jj) S[mi][ni][jj] = rowsel ? S[mi][ni][jj] : -1e30f; }
    }
#pragma unroll
    for (int mi = 0; mi < 2; ++mi) { float mx = -1e30f;
#pragma unroll
        for (int ni = 0; ni < 4; ++ni)
#pragma unroll
            for (int jj = 0; jj < 4; ++jj) mx = fmaxf(mx, S[mi][ni][jj]);
        mx = fmaxf(mx, __shfl_xor(mx, 16)); mx = fmaxf(mx, __shfl_xor(mx, 32));
        const float mnew = fmaxf(m[mi], mx); const float alpha = __builtin_amdgcn_exp2f(m[mi] - mnew); const float msub = fmaxf(mnew, -1e29f); float sum = 0.f;
#pragma unroll
        for (int ni = 0; ni < 4; ++ni)
#pragma unroll
            for (int jj = 0; jj < 4; ++jj) { const float pv = __builtin_amdgcn_exp2f(S[mi][ni][jj] - msub); S[mi][ni][jj] = pv; sum += pv; }
        sum += __shfl_xor(sum, 16); sum += __shfl_xor(sum, 32);
        lsum[mi] = lsum[mi] * alpha + sum; m[mi] = mnew;
#pragma unroll
        for (int ei = 0; ei < 4; ++ei) O[mi][ei] *= alpha; }
#pragma unroll
    for (int ks2 = 0; ks2 < 2; ++ks2)
#pragma unroll
        for (int ei = 0; ei < 4; ++ei) { const bf16x8 vf = ldfrag_tr(VT, 72, (2 * ks2) * 16, (2 * ks2 + 1) * 16, ei * 16, fq * 16 + fr);
#pragma unroll
            for (int mi = 0; mi < 2; ++mi) O[mi][ei] = MF(vf, packfrag(S[mi][2 * ks2], S[mi][2 * ks2 + 1]), O[mi][ei]); }
}
__device__ __forceinline__ void kv_load(u32x4& kr, u32x4& vr, const bf16_t* projb, int j, int kcol, int vcol, int tid) {
    const int row = tid >> 3, ch = tid & 7; const bf16_t* src = projb + (size_t)(64 * j + row) * PLD;
    kr = *(const u32x4*)(src + kcol + ch * 8); vr = *(const u32x4*)(src + vcol + ch * 8);
}
__device__ __forceinline__ void kv_store(lptr Ks, lptr VT, const u32x4 kr, const u32x4 vr, int tid) {
    const int row = tid >> 3, ch = tid & 7;
    *(LAS u32x4*)(Ks + ((size_t)row * 72 + ch * 8) * 2) = kr;
    *(LAS u32x4*)(VT + ((size_t)row * 72 + ch * 8) * 2) = vr;
}
__device__ __forceinline__ void nsa_item(const Params& p, int l, int item, lptr lds) {
    int tid_ = threadIdx.x; asm volatile("" : "+v"(tid_)); const int tid = tid_, wave = __builtin_amdgcn_readfirstlane(tid >> 6), lane = tid & 63, fr = lane & 15, fq = lane >> 4;
    const int qt = item & 31, g = (item >> 5) & 1, b = item >> 6; const int t0 = qt * 64, cur = qt;
    const bf16_t* projb = (const bf16_t*)(p.ws + WS_PROJ) + (size_t)b * SEQ * PLD; bf16_t* ys = (bf16_t*)(p.ws + WS_YS);
    const bf16_t* kcmp = (const bf16_t*)(p.ws + WS_KCMP) + (size_t)(b * 2 + g) * 8192; const bf16_t* vcmpT = (const bf16_t*)(p.ws + WS_VCMPT) + (size_t)(b * 2 + g) * 8192;
    lptr Ks = lds, VT = lds + 9216, Ks1 = lds + 125184, VT1 = lds + 134400; LAS float* Pc = (LAS float*)(lds + 18432); LAS unsigned* selm = (LAS unsigned*)(lds + 52224); lptr Kc = lds + 52480, VcT = lds + 70912;
    const int r = wave >> 1, qh = wave & 1, hh = g * 4 + r; const float slope = exp2f(-(float)(hh + 1)) * 1.4426950408889634f;
    int trow[2]; lptr Qs = lds + 88320; const int qrow = wave * 32;
#pragma unroll
    for (int mi = 0; mi < 2; ++mi) { trow[mi] = t0 + qh * 32 + mi * 16 + fr;
#pragma unroll
        for (int ks = 0; ks < 2; ++ks) *(LAS bf16x8*)(Qs + ((size_t)(qrow + mi * 16 + fr) * 72 + ks * 32 + fq * 8) * 2) = *(const bf16x8*)(projb + (size_t)trow[mi] * PLD + C_Q + hh * 64 + ks * 32 + fq * 8);
    }
#define GATE(mi, i) sigmoidf_(bf2f(projb[(size_t)trow[mi] * PLD + C_GATE + hh * 3 + (i)]))
    f32x4 outa[2][4];
#pragma unroll
    for (int k = 0; k < 2; ++k) { const int idx = tid + k * 512;
        { const int row = idx >> 3, ch = idx & 7; *(LAS u32x4*)(Kc + ((size_t)row * 72 + ch * 8) * 2) = *(const u32x4*)(kcmp + row * 64 + ch * 8); }
        { const int row = idx >> 4, ch = idx & 15; *(LAS u32x4*)(VcT + ((size_t)row * 136 + ch * 8) * 2) = *(const u32x4*)(vcmpT + row * 128 + ch * 8); } }
    __syncthreads();
    {
        f32x4 S[2][8];
#pragma unroll
        for (int mi = 0; mi < 2; ++mi)
#pragma unroll
            for (int ni = 0; ni < 8; ++ni) S[mi][ni] = (f32x4){0.f, 0.f, 0.f, 0.f};
#pragma unroll
        for (int ks = 0; ks < 2; ++ks)
#pragma unroll
            for (int ni = 0; ni < 8; ++ni) { const bf16x8 kf = ldfrag(Kc, (ni * 16 + fr) * 72 + ks * 32 + fq * 8);
#pragma unroll
                for (int mi = 0; mi < 2; ++mi) S[mi][ni] = MF(kf, ldfrag(Qs, (qrow + mi * 16 + fr) * 72 + ks * 32 + fq * 8), S[mi][ni]); }
#pragma unroll
        for (int mi = 0; mi < 2; ++mi) { const int t = trow[mi]; float mx = -1e30f;
#pragma unroll
            for (int ni = 0; ni < 8; ++ni)
#pragma unroll
                for (int jj = 0; jj < 4; ++jj) { const int ci = ni * 16 + fq * 4 + jj; const bool valid = (16 * ci + 31 <= t);
                    const float s = valid ? S[mi][ni][jj] - slope * ((float)t - (16.f * (float)ci + 15.5f)) : -1e30f; S[mi][ni][jj] = s; mx = fmaxf(mx, s); }
            mx = fmaxf(mx, __shfl_xor(mx, 16)); mx = fmaxf(mx, __shfl_xor(mx, 32)); float sum = 0.f;
#pragma unroll
            for (int ni = 0; ni < 8; ++ni)
#pragma unroll
                for (int jj = 0; jj < 4; ++jj) { const float s = S[mi][ni][jj]; const float pv = s > -1e29f ? __builtin_amdgcn_exp2f(s - mx) : 0.f; S[mi][ni][jj] = pv; sum += pv; }
            sum += __shfl_xor(sum, 16); sum += __shfl_xor(sum, 32); const float inv = sum > 0.f ? 1.f / sum : 0.f;
#pragma unroll
            for (int ni = 0; ni < 8; ++ni) S[mi][ni] *= inv; }
#pragma unroll 1
        for (int rr = 0; rr < 4; ++rr) {
            if (r == rr) {
#pragma unroll
                for (int mi = 0; mi < 2; ++mi)
#pragma unroll
                    for (int ni = 0; ni < 8; ++ni) { LAS f32x4* dst = (LAS f32x4*)(Pc + (qh * 32 + mi * 16 + fr) * 132 + ni * 16 + fq * 4); if (rr == 0) *dst = S[mi][ni]; else *dst = *dst + S[mi][ni]; } }
            __syncthreads(); }
        bf16x8 pf[2][4];
#pragma unroll
        for (int mi = 0; mi < 2; ++mi)
#pragma unroll
            for (int ks2 = 0; ks2 < 4; ++ks2) pf[mi][ks2] = packfrag(S[mi][2 * ks2], S[mi][2 * ks2 + 1]);
        f32x4 O[2][4];
#pragma unroll
        for (int mi = 0; mi < 2; ++mi)
#pragma unroll
            for (int ei = 0; ei < 4; ++ei) O[mi][ei] = (f32x4){0.f, 0.f, 0.f, 0.f};
#pragma unroll
        for (int ks2 = 0; ks2 < 4; ++ks2)
#pragma unroll
            for (int ei = 0; ei < 4; ++ei) { const bf16x8 vf = ldfrag2(VcT, (ei * 16 + fr) * 136 + (2 * ks2) * 16 + fq * 4, (ei * 16 + fr) * 136 + (2 * ks2 + 1) * 16 + fq * 4);
#pragma unroll
                for (int mi = 0; mi < 2; ++mi) O[mi][ei] = MF(vf, pf[mi][ks2], O[mi][ei]); }
        const float g0v[2] = {GATE(0, 0), GATE(1, 0)};
#pragma unroll
        for (int mi = 0; mi < 2; ++mi)
#pragma unroll
            for (int ei = 0; ei < 4; ++ei) outa[mi][ei] = O[mi][ei] * g0v[mi];
    }
    if (wave == 0) { const int q = lane; const LAS float* pr = Pc + q * 132; float sc[32];
#pragma unroll
        for (int n = 0; n < 32; ++n) { float im = 0.f;
#pragma unroll
            for (int cc = 4 * n - 1; cc <= 4 * n + 3; ++cc) if (cc >= 0 && cc <= 126) im += pr[cc];
            const bool forced = (n == 0) || (n == cur) || (n == cur - 1);
            sc[n] = forced ? 1e9f : (n <= cur ? im : -1e30f); }
        unsigned mask = 0u;
#pragma unroll
        for (int it = 0; it < 8; ++it) { float best = -3e38f; int bi = 0;
#pragma unroll
            for (int n = 0; n < 32; ++n) if (sc[n] > best) { best = sc[n]; bi = n; }
            mask |= 1u << bi;
#pragma unroll
            for (int n = 0; n < 32; ++n) if (n == bi) sc[n] = -3e38f; }
        selm[q] = mask; }
    __syncthreads();
    unsigned U = selm[lane];
#pragma unroll
    for (int o = 32; o >= 1; o >>= 1) U |= __shfl_xor(U, o);
    U = __builtin_amdgcn_readfirstlane(U);
    const LAS unsigned* selq = selm + qh * 32;
    {
        float m[2] = {-1e30f, -1e30f}, ls[2] = {0.f, 0.f}; f32x4 O[2][4];
#pragma unroll
        for (int mi = 0; mi < 2; ++mi)
#pragma unroll
            for (int ei = 0; ei < 4; ++ei) O[mi][ei] = (f32x4){0.f, 0.f, 0.f, 0.f};
        { const unsigned Uv = cur >= 31 ? U : (U & ((2u << cur) - 1u));
          unsigned rem = Uv; int j = __builtin_ctz(rem); rem &= rem - 1u;
          u32x4 kr, vr; kv_load(kr, vr, projb, j, C_KS + g * 64, C_VS + g * 64, tid);
          kv_store(Ks, VT, kr, vr, tid); __syncthreads();
          int jn = rem ? __builtin_ctz(rem) : -1; rem &= rem - 1u;
          if (jn >= 0) kv_load(kr, vr, projb, jn, C_KS + g * 64, C_VS + g * 64, tid);
          int cb = 0;
#pragma unroll 1
          for (;;) {
              int jnn = -1;
              if (jn >= 0) { kv_store(cb ? Ks : Ks1, cb ? VT : VT1, kr, vr, tid); jnn = rem ? __builtin_ctz(rem) : -1; rem &= rem - 1u;
                  if (jnn >= 0) kv_load(kr, vr, projb, jnn, C_KS + g * 64, C_VS + g * 64, tid); }
              attn_tile<1>(cb ? Ks1 : Ks, cb ? VT1 : VT, Qs, qrow, trow, slope, j, true, selq, m, ls, O, fr, fq);
              __syncthreads();
              if (jn < 0) break; j = jn; jn = jnn; cb ^= 1; } }
#pragma unroll
        for (int mi = 0; mi < 2; ++mi) { const float sc = GATE(mi, 1) / ls[mi];
#pragma unroll
            for (int ei = 0; ei < 4; ++ei) outa[mi][ei] += O[mi][ei] * sc; }
    }
    {
        float m[2] = {-1e30f, -1e30f}, ls[2] = {0.f, 0.f}; f32x4 O[2][4];
#pragma unroll
        for (int mi = 0; mi < 2; ++mi)
#pragma unroll
            for (int ei = 0; ei < 4; ++ei) O[mi][ei] = (f32x4){0.f, 0.f, 0.f, 0.f};
        { int j = cur > 4 ? cur - 4 : 0;
          u32x4 kr, vr; kv_load(kr, vr, projb, j, C_KW + g * 64, C_VW + g * 64, tid);
          kv_store(Ks, VT, kr, vr, tid); __syncthreads();
          if (j < cur) kv_load(kr, vr, projb, j + 1, C_KW + g * 64, C_VW + g * 64, tid);
          int cb = 0;
#pragma unroll 1
          for (;;) {
              if (j < cur) { kv_store(cb ? Ks : Ks1, cb ? VT : VT1, kr, vr, tid); if (j + 1 < cur) kv_load(kr, vr, projb, j + 2, C_KW + g * 64, C_VW + g * 64, tid); }
              attn_tile<2>(cb ? Ks1 : Ks, cb ? VT1 : VT, Qs, qrow, trow, slope, j, true, selq, m, ls, O, fr, fq);
              __syncthreads();
              if (j >= cur) break; ++j; cb ^= 1; } }
#pragma unroll
        for (int mi = 0; mi < 2; ++mi) { const float sc = GATE(mi, 2) / ls[mi];
#pragma unroll
            for (int ei = 0; ei < 4; ++ei) outa[mi][ei] += O[mi][ei] * sc; }
    }
#pragma unroll
    for (int mi = 0; mi < 2; ++mi)
#pragma unroll
        for (int ei = 0; ei < 4; ++ei) { u32x2 o; o.x = pk2(outa[mi][ei][0], outa[mi][ei][1]); o.y = pk2(outa[mi][ei][2], outa[mi][ei][3]);
            *(u32x2*)(ys + ((size_t)b * SEQ + trow[mi]) * YLD + 1024 + hh * 64 + ei * 16 + fq * 4) = o; }
    __syncthreads();
}

__device__ __forceinline__ void convmod_item(const Params& p, int l, int item, lptr lds) {
    int tid_ = threadIdx.x; asm volatile("" : "+v"(tid_)); const int tid = tid_, wave = __builtin_amdgcn_readfirstlane(tid >> 6), lane = tid & 63;
    const int b = item >> 6, sp0 = (item & 63) * 32;
    const bf16_t* projb = (const bf16_t*)(p.ws + WS_PROJ) + (size_t)b * SEQ * PLD; bf16_t* ys = (bf16_t*)(p.ws + WS_YS);
    lptr glu = lds; LAS float* yf = (LAS float*)(lds + 63488);
#pragma unroll 4
    for (int idx = tid; idx < 62 * 64; idx += NT) { const int j = idx >> 6, c8 = (idx & 63) * 8; const int sp = sp0 - 30 + j; float o[8];
        if (sp >= 0) { float a[8], bb[8]; unpack8(*(const u32x4*)(projb + (size_t)sp * PLD + C_AB + c8), a); unpack8(*(const u32x4*)(projb + (size_t)sp * PLD + C_AB + 512 + c8), bb);
#pragma unroll
            for (int e = 0; e < 8; ++e) o[e] = a[e] * sigmoidf_(bb[e]); }
        else {
#pragma unroll
            for (int e = 0; e < 8; ++e) o[e] = 0.f; }
        *(LAS u32x4*)(glu + ((size_t)j * 512 + c8) * 2) = pack8(o); }
    __syncthreads();
    { const int cp = tid & 255, half = tid >> 8; const float* cw = p.in[I_CDW] + (size_t)l * 31 * 512 + 2 * cp;
      float w[31][2];
#pragma unroll
      for (int k = 0; k < 31; ++k) { const f32x2 t = *(const f32x2*)(cw + k * 512); w[k][0] = t.x; w[k][1] = t.y; }
      const f32x2 bs = *(const f32x2*)(p.in[I_CDB] + l * 512 + 2 * cp);
      float acc[16][2];
#pragma unroll
      for (int t = 0; t < 16; ++t) { acc[t][0] = bs.x; acc[t][1] = bs.y; }
#pragma unroll
      for (int jj = 0; jj < 46; ++jj) { const unsigned gw = *(const LAS unsigned*)(glu + ((size_t)(half * 16 + jj) * 512 + 2 * cp) * 2); const float g0 = lo16(gw), g1 = hi16(gw);
#pragma unroll
          for (int t = 0; t < 16; ++t) { const int k = jj - t; if (k >= 0 && k <= 30) { acc[t][0] += w[k][0] * g0; acc[t][1] += w[k][1] * g1; } } }
#pragma unroll
      for (int t = 0; t < 16; ++t) *(LAS f32x2*)(yf + (half * 16 + t) * 516 + 2 * cp) = (f32x2){acc[t][0], acc[t][1]}; }
    __syncthreads();
    for (int rr = 0; rr < 4; ++rr) { const int t = wave * 4 + rr; const LAS float* yr = yf + t * 516 + lane * 8; const f32x4 a = *(const LAS f32x4*)yr, bb = *(const LAS f32x4*)(yr + 4);
        float f[8] = {a.x, a.y, a.z, a.w, bb.x, bb.y, bb.z, bb.w}; float ss = 0.f;
#pragma unroll
        for (int e = 0; e < 8; ++e) ss += f[e] * f[e];
        ss = wave_sum(ss); const float rs = rsqrtf(ss * (1.f / 512.f) + EPS); const float* gn = p.in[I_CNORM] + l * 512 + lane * 8;
#pragma unroll
        for (int e = 0; e < 8; ++e) f[e] = siluf_(f[e] * rs * gn[e]);
        *(u32x4*)(ys + ((size_t)b * SEQ + sp0 + t) * YLD + 1536 + lane * 8) = pack8(f); }
    __syncthreads();
}

__global__ void __launch_bounds__(NT, 2) mega(Params p) {
    extern __shared__ __attribute__((aligned(16))) unsigned char lds_raw[];
    lptr lds = (lptr)lds_raw;
    cg::grid_group grid = cg::this_grid();
    int G = gridDim.x, c = blockIdx.x;
    unsigned char* ws = p.ws;
    volatile LAS unsigned* bst = (volatile LAS unsigned*)(lds + LDS_BYTES - 16);
    if (threadIdx.x < 4) bst[threadIdx.x] = 0u;
    __syncthreads();
    const XcdBarrier xbar = xcd_barrier_post((unsigned*)(p.ws + WS_BAR), bst);
    grid.sync();

#define OPQ() asm volatile("" : "+s"(G), "+s"(c), "+s"(l), "+s"(ws))
    bf16_t* xn = (bf16_t*)(ws + WS_XN); bf16_t* proj = (bf16_t*)(ws + WS_PROJ); bf16_t* hid = proj; unsigned char* gates = (unsigned char*)(ws + WS_GATES);
    bf16_t* ysb = (bf16_t*)(ws + WS_YS); float* mf = (float*)(ws + WS_PROJ); bf16_t* merged = (bf16_t*)(ws + WS_MERGED);
    float* x = p.out;
    const LAS float* rstl_c = (const LAS float*)(lds + 131072); LAS float* rstl = (LAS float*)(lds + 131072);
    float* rsqA = (float*)(ws + WS_RSQ); float* rsqB = rsqA + NTOK * 16; float* rsqC = rsqB + NTOK * 16;
    for (int li = 0; li < NLAYER; ++li) {
        int l = li; OPQ();
        const float* xin = l == 0 ? p.in[I_X] : x;
        if (l == 0) { convert_phase(p, 0, lds); norm_phase(xin, p.in[I_F1N], xn, rsqA);
            xcd_barrier(xbar); OPQ(); }
        { pg8::Gemm g{xn, (const bf16_t*)(ws + WS_W1IN), DM, DM}; pg8::StaticOrder S; S.init(NTOK, NFF, G, c); rstd_prologue(S, rsqA, rstl); pg8::EpiSwiglu E{hid, rstl}; pg8::gemm_phase(lds, g, S, E); }
        xcd_barrier(xbar); OPQ();
        { pg8::Gemm g{hid, (const bf16_t*)(ws + WS_W1OUT), FF, FF}; pg8::StaticOrder S; S.init(NTOK, DM, G, c); pg8::EpiResid E{xin, x, 0.5f, xn, p.in[I_MIXN] + l * DM, rsqB}; pg8::gemm_phase(lds, g, S, E); }
        xcd_barrier(xbar); OPQ();
        { pg8::Gemm g{xn, (const bf16_t*)(ws + WS_WIN), DM, DM}; pg8::StaticOrder S; S.init(NTOK, NIN, G, c); rstd_prologue(S, rsqB, rstl); pg8::EpiInproj E{proj, gates, rstl}; pg8::gemm_phase(lds, g, S, E); }
        xcd_barrier(xbar); OPQ();
        {
            if (MIX_MASK & 4) qknorm_pass(proj, p.in[I_QN] + l * 64, p.in[I_KN] + l * 64);
            constexpr int N_CMP = 64, N_SGU = 128, N_MB1 = 256, N_CV = 512, N_TOT = N_CMP + N_SGU + N_MB1 + N_CV;
            unsigned* ctr = (unsigned*)(ws + WS_BAR + 14336) + (l * 2) * 64;
            int qpar = 0;
            for (int it = c; it < N_TOT; ) { int r = it;
                unsigned nxt_it = 0u; if (threadIdx.x == 0) nxt_it = G + atomicAdd(ctr, 1u);
                if (r < N_CMP) { if (MIX_MASK & 4) compress_item(p, l, r, lds); }
                else if ((r -= N_CMP) < N_SGU) { if (MIX_MASK & 1) sgu_item(p, l, r, lds); }
                else if ((r -= N_SGU) < N_MB1) { if (MIX_MASK & 2) mamba1_item(p, l, r, lds); }
                else { r -= N_MB1; if (MIX_MASK & 8) convmod_item(p, l, r, lds); }
                if (threadIdx.x == 0) bst[2 + qpar] = nxt_it;
                __syncthreads(); it = (int)bst[2 + qpar]; qpar ^= 1; }
        }
        xcd_barrier(xbar); OPQ();
        if (MIX_MASK & 2) prefix_phase(p);
        xcd_barrier(xbar); OPQ();
        {
            constexpr int N_MB2 = 128, N_ATT = 512, N_CVB = (CV_NB + 31) / 32, N_CVA = (CV_NA + 31) / 32;
            unsigned* ctr = (unsigned*)(ws + WS_BAR + 14336) + (l * 2 + 1) * 64;
            const int n_tot = N_MB2 + N_ATT + N_CVB + (l < NLAYER - 1 ? N_CVA : 0);
            int qpar = 0;
            for (int it = c; it < n_tot; ) { int r = it;
                unsigned nxt_it = 0u; if (threadIdx.x == 0) nxt_it = G + atomicAdd(ctr, 1u);
                if (r < N_MB2) { if (MIX_MASK & 2) mamba2_item(p, l, r, lds); }
                else if ((r -= N_MB2) < N_ATT) { const int qt = 31 - (r >> 4), bg = r & 15; if (MIX_MASK & 4) nsa_item(p, l, (bg << 5) | qt, lds); }
                else convert_wg_item(p, l, r - N_ATT, lds);
                if (threadIdx.x == 0) bst[2 + qpar] = nxt_it;
                __syncthreads(); it = (int)bst[2 + qpar]; qpar ^= 1; }
        }
        xcd_barrier(xbar); OPQ();
        { pg8::Gemm g{ysb, (const bf16_t*)(ws + WS_WB), YLD, 512}; pg8::MergeOrder S; S.init(G, c); pg8::EpiMerge E{gates, merged}; pg8::gemm_phase(lds, g, S, E); }
        xcd_barrier(xbar); OPQ();
        { pg8::Gemm g{merged, (const bf16_t*)(ws + WS_WO), DM, DM}; pg8::StaticOrder S; S.init(NTOK, DM, G, c); pg8::EpiResid E{x, x, 1.0f, xn, p.in[I_F2N] + l * DM, rsqC}; pg8::gemm_phase(lds, g, S, E); }
        xcd_barrier(xbar); OPQ();
        { pg8::Gemm g{xn, (const bf16_t*)(ws + WS_W2IN), DM, DM}; pg8::StaticOrder S; S.init(NTOK, NFF, G, c); rstd_prologue(S, rsqC, rstl); pg8::EpiSwiglu E{hid, rstl}; pg8::gemm_phase(lds, g, S, E); }
        xcd_barrier(xbar); OPQ();
        { const bool lastl = (l == NLAYER - 1); pg8::Gemm g{hid, (const bf16_t*)(ws + WS_W2OUT), FF, FF}; pg8::StaticOrder S; S.init(NTOK, DM, G, c);
          pg8::EpiResid E{x, x, 0.5f, lastl ? (bf16_t*)nullptr : xn, p.in[I_F1N] + (lastl ? l : l + 1) * DM, rsqA}; pg8::gemm_phase(lds, g, S, E); }
        if (l < NLAYER - 1) { xcd_barrier(xbar); OPQ(); }
    }
}

extern "C" void kernel_launch(void* const* d_in, const int* in_sizes, int n_in, void* d_out, int out_size, void* d_ws, size_t ws_size, hipStream_t stream) {
    static int grid_blocks = 0;
    if (grid_blocks == 0) {
        if (n_in != 31 || out_size != NTOK * DM || ws_size < WS_END) { fprintf(stderr, "kernel_launch: unexpected shapes (n_in %d, out %d, ws %zu need %zu)\n", n_in, out_size, ws_size, (size_t)WS_END); grid_blocks = -1; return; }
        int dev = 0, cus = 0, per_cu = 0;
        hipGetDevice(&dev);
        hipDeviceGetAttribute(&cus, hipDeviceAttributeMultiprocessorCount, dev);
        if (hipFuncSetAttribute((const void*)mega, hipFuncAttributeMaxDynamicSharedMemorySize, LDS_BYTES) != hipSuccess) { fprintf(stderr, "kernel_launch: hipFuncSetAttribute failed\n"); grid_blocks = -1; return; }
        if (hipOccupancyMaxActiveBlocksPerMultiprocessor(&per_cu, (const void*)mega, NT, LDS_BYTES) != hipSuccess || per_cu < 1) { fprintf(stderr, "kernel_launch: occupancy query gave %d\n", per_cu); per_cu = 1; }
        (void)hipGetLastError();
        grid_blocks = cus * 1;
        (void)per_cu;
    }
    if (grid_blocks < 0) return;
    Params p{};
    for (int i = 0; i < 31; ++i) p.in[i] = (const float*)d_in[i];
    p.out = (float*)d_out; p.ws = (unsigned char*)d_ws;
    if (hipMemsetAsync((char*)d_ws + WS_BAR, 0, 16384, stream) != hipSuccess) { fprintf(stderr, "kernel_launch: memset failed\n"); return; }
    void* args[] = {&p};
    hipError_t e = hipLaunchCooperativeKernel((const void*)mega, dim3(grid_blocks), dim3(NT), args, LDS_BYTES, stream);
    if (e != hipSuccess) fprintf(stderr, "cooperative launch failed: %s (grid %d)\n", hipGetErrorString(e), grid_blocks);
}
```

```cpp
#include <hip/hip_runtime.h>
#include <hip/hip_cooperative_groups.h>
#include <cstdio>
namespace cg = cooperative_groups;

#define LAS __attribute__((address_space(3)))
typedef unsigned short bf16_t;
typedef short bf16x8 __attribute__((ext_vector_type(8)));
typedef float f32x4 __attribute__((ext_vector_type(4)));
typedef float f32x2 __attribute__((ext_vector_type(2)));
typedef unsigned u32x4 __attribute__((ext_vector_type(4)));
typedef unsigned u32x2 __attribute__((ext_vector_type(2)));
typedef LAS unsigned char* lptr;

#ifndef GEMM_ALIGN
#define GEMM_ALIGN true
#endif
#ifndef GEMM_SP2
#define GEMM_SP2 true
#endif
#ifndef PROBE_REP
#define PROBE_REP 1
#endif
#ifndef MIX_MASK
#define MIX_MASK 15
#endif

constexpr int NTOK = 16384, SEQ = 2048, DM = 1024, FF = 2816, NFF = 5632, PLD = 4896, NIN = 9216, NLAYER = 4;
constexpr int YLD = 2048;
constexpr int NT = 512;
constexpr int LDS_BYTES = 147456;
constexpr float EPS = 1e-6f;
constexpr int C_U = 0, C_V = 512, C_Z = 1024, C_XBC = 1536, C_Q = 2560, C_KC = 3072, C_VC = 3200, C_KS = 3328, C_VS = 3456, C_KW = 3584, C_VW = 3712,
              C_AB = 3840, C_DT = 4864, C_GATE = 4872;

constexpr size_t WS_W1IN = 0;
constexpr size_t WS_W1OUT = WS_W1IN + (size_t)NFF * DM * 2;
constexpr size_t WS_WIN = WS_W1OUT + (size_t)DM * FF * 2;
constexpr size_t WS_WB = WS_WIN + (size_t)NIN * DM * 2;
constexpr size_t WS_WO = WS_WB + (size_t)4096 * 512 * 2;
constexpr size_t WS_W2IN = WS_WO + (size_t)DM * DM * 2;
constexpr size_t WS_W2OUT = WS_W2IN + (size_t)NFF * DM * 2;
constexpr size_t WS_WC1K = WS_W2OUT + (size_t)DM * FF * 2;
constexpr size_t WS_WC1V = WS_WC1K + (size_t)128 * 2048 * 2;
constexpr size_t WS_WC2K = WS_WC1V + (size_t)128 * 2048 * 2;
constexpr size_t WS_WC2V = WS_WC2K + (size_t)64 * 128 * 2;
constexpr size_t WS_WEND = WS_WC2V + (size_t)64 * 128 * 2;
constexpr size_t WS_XN = 64ull << 20;
constexpr size_t WS_PROJ = WS_XN + (size_t)NTOK * DM * 2;
constexpr size_t WS_MERGED = WS_PROJ + (size_t)NTOK * DM * 4;
constexpr size_t WS_GATES = WS_PROJ + (size_t)NTOK * PLD * 2;
constexpr size_t WS_YS = WS_GATES + (size_t)NTOK * 4096 * 2;
constexpr size_t WS_STATES = WS_YS + (size_t)NTOK * YLD * 2;
constexpr size_t WS_ATOT = WS_STATES + (size_t)8 * 16 * 8 * 64 * 128 * 4;
constexpr size_t WS_KCMP = WS_ATOT + 4096;
constexpr size_t WS_VCMPT = WS_KCMP + (size_t)8 * 2 * 128 * 64 * 2;
constexpr size_t WS_SINB = WS_VCMPT + (size_t)8 * 2 * 128 * 64 * 2;
constexpr size_t WS_RSQ = WS_SINB + (size_t)8 * 16 * 8 * 8192 * 2;
constexpr size_t WS_BAR = WS_RSQ + 3 * 16 * 65536;
constexpr size_t WS_END = WS_BAR + 16384;
static_assert(WS_WEND <= WS_XN, "weights region");

struct Params {
    const float* in[31];
    float* out;
    unsigned char* ws;
};
enum { I_X = 0, I_F1N, I_F1WI, I_F1WO, I_MIXN, I_WIN, I_SGUVN, I_SGUW, I_SGUB, I_SCW, I_SCB, I_SDTB, I_SALOG, I_SD, I_SNORM, I_QN, I_KN, I_PEK, I_W1K, I_W2K,
       I_PEV, I_W1V, I_W2V, I_CDW, I_CDB, I_CNORM, I_WBR, I_WOUT, I_F2N, I_F2WI, I_F2WO };

__device__ __forceinline__ float bf2f(bf16_t b) { return __uint_as_float(((unsigned)b) << 16); }
typedef __bf16 bf16x2_t __attribute__((ext_vector_type(2)));
__device__ __forceinline__ unsigned pk2(float lo, float hi) { const f32x2 v = {lo, hi}; const bf16x2_t b = __builtin_convertvector(v, bf16x2_t); return __builtin_bit_cast(unsigned, b); }
__device__ __forceinline__ bf16_t f2bf(float f) { return (bf16_t)(pk2(f, 0.f) & 0xffffu); }
__device__ __forceinline__ float lo16(unsigned w) { return __uint_as_float(w << 16); }
__device__ __forceinline__ float hi16(unsigned w) { return __uint_as_float(w & 0xffff0000u); }
__device__ __forceinline__ void unpack8(u32x4 v, float* f) { f[0] = lo16(v.x); f[1] = hi16(v.x); f[2] = lo16(v.y); f[3] = hi16(v.y); f[4] = lo16(v.z); f[5] = hi16(v.z); f[6] = lo16(v.w); f[7] = hi16(v.w); }
__device__ __forceinline__ u32x4 pack8(const float* f) { u32x4 o; o.x = pk2(f[0], f[1]); o.y = pk2(f[2], f[3]); o.z = pk2(f[4], f[5]); o.w = pk2(f[6], f[7]); return o; }
__device__ __forceinline__ float rcpf(float x) { return __builtin_amdgcn_rcpf(x); }
__device__ __forceinline__ float sigmoidf_(float x) { return rcpf(1.0f + __expf(-x)); }
__device__ __forceinline__ float siluf_(float x) { return x * sigmoidf_(x); }
__device__ __forceinline__ float gelu_tanh(float v) { const float u = 0.7978845608f * (v + 0.044715f * v * v * v); return v * rcpf(1.0f + __expf(-2.0f * u)); }
__device__ __forceinline__ float wave_sum(float v) {
#pragma unroll
    for (int o = 32; o >= 1; o >>= 1) v += __shfl_xor(v, o);
    return v;
}
__device__ __forceinline__ f32x4 MF(bf16x8 a, bf16x8 b, f32x4 c) { return __builtin_amdgcn_mfma_f32_16x16x32_bf16(a, b, c, 0, 0, 0); }
__device__ __forceinline__ bf16x8 ldfrag(lptr base, int off_elems) { return *(const LAS bf16x8*)(base + (size_t)off_elems * 2); }
__device__ __forceinline__ bf16x8 ldfrag2(lptr base, int off0, int off1) {
    const u32x2 a = *(const LAS u32x2*)(base + (size_t)off0 * 2), b = *(const LAS u32x2*)(base + (size_t)off1 * 2);
    u32x4 v; v.x = a.x; v.y = a.y; v.z = b.x; v.w = b.y; return __builtin_bit_cast(bf16x8, v);
}
typedef short s16x4 __attribute__((ext_vector_type(4)));
__device__ __forceinline__ bf16x8 ldfrag_tr(lptr base, int ld, int k0, int k1, int n0, int lane) {
    const int g = lane >> 4, q = (lane & 15) >> 2, pp = lane & 3;
    const LAS s16x4* a0 = (const LAS s16x4*)(base + (size_t)((k0 + 4 * g + q) * ld + n0 + 4 * pp) * 2);
    const LAS s16x4* a1 = (const LAS s16x4*)(base + (size_t)((k1 + 4 * g + q) * ld + n0 + 4 * pp) * 2);
    const s16x4 lo = __builtin_amdgcn_ds_read_tr16_b64_v4i16((LAS s16x4*)a0), hi = __builtin_amdgcn_ds_read_tr16_b64_v4i16((LAS s16x4*)a1);
    bf16x8 r; r[0] = lo[0]; r[1] = lo[1]; r[2] = lo[2]; r[3] = lo[3]; r[4] = hi[0]; r[5] = hi[1]; r[6] = hi[2]; r[7] = hi[3]; return r;
}
__device__ __forceinline__ bf16x8 packfrag(f32x4 t0, f32x4 t1) { u32x4 v; v.x = pk2(t0[0], t0[1]); v.y = pk2(t0[2], t0[3]); v.z = pk2(t1[0], t1[1]); v.w = pk2(t1[2], t1[3]); return __builtin_bit_cast(bf16x8, v); }
__device__ __forceinline__ void lds_st16(lptr p, bf16_t v) { *(LAS bf16_t*)p = v; }


#define XB_TMO      128
#define XB_XCNT(j)  (256  + 64 * (j))
#define XB_XSUB(j)  (1280 + 64 * (j))
#define XB_XGEN(j)  (2304 + 64 * (j))
#define XB_TOP      3328
#define XB_TOPGEN   3392
#define XCD_BAR_WORDS 3456
#define XB_SPIN_CAP (1u << 22)
__device__ __forceinline__ unsigned xb_ld(unsigned* p)              { return __hip_atomic_load(p, __ATOMIC_RELAXED, __HIP_MEMORY_SCOPE_AGENT); }
__device__ __forceinline__ unsigned xb_add(unsigned* p, unsigned v) { return __hip_atomic_fetch_add(p, v, __ATOMIC_RELAXED, __HIP_MEMORY_SCOPE_AGENT); }
__device__ __forceinline__ unsigned xb_xcc_id() { return (unsigned)__builtin_amdgcn_s_getreg((3 << 11) | 20) & 0xFu; }
#define XB_SPIN(cond, bar) do { unsigned _sp = 0; while (cond) { __builtin_amdgcn_s_sleep(1); \
    if ((++_sp & 255u) == 0u) { if (xb_ld(&(bar)[XB_TMO])) break; if (_sp > XB_SPIN_CAP) { atomicAdd(&(bar)[XB_TMO], 1u); break; } } } } while (0)
struct XcdBarrier { unsigned* bar; unsigned x; volatile LAS unsigned* st; };
__device__ __forceinline__ XcdBarrier xcd_barrier_post(unsigned* bar, volatile LAS unsigned* st) {
    XcdBarrier b; b.bar = bar; b.x = xb_xcc_id(); b.st = st;
    if (threadIdx.x == 0) (void)xb_add(&bar[XB_XCNT(b.x)], 1u);
    return b;
}
__device__ __forceinline__ void xcd_barrier_complete(unsigned* bar, unsigned x, unsigned& nloc, unsigned& nx) {
    const unsigned G = gridDim.x * gridDim.y * gridDim.z;
    unsigned sum, cnt, mine, sp = 0u;
    for (;;) {
        sum = 0u; cnt = 0u; mine = 0u;
#pragma unroll
        for (unsigned j = 0; j < 16; ++j) { const unsigned c = xb_ld(&bar[XB_XCNT(j)]); sum += c; cnt += (c > 0u) ? 1u : 0u; mine = (j == x) ? c : mine; }
        if (sum == G) break;
        __builtin_amdgcn_s_sleep(1);
        if ((++sp & 255u) == 0u) { if (xb_ld(&bar[XB_TMO])) break; if (sp > XB_SPIN_CAP) { atomicAdd(&bar[XB_TMO], 1u); break; } }
    }
    nloc = mine > 0u ? mine : 1u; nx = cnt > 0u ? cnt : 1u;
}
__device__ __forceinline__ void xcd_barrier(const XcdBarrier& b) {
    asm volatile("s_waitcnt vmcnt(0)" ::: "memory");
    __syncthreads();
    if (threadIdx.x == 0) {
        unsigned* bar = b.bar;
        __builtin_amdgcn_s_waitcnt(0);
        unsigned nloc = b.st[0], nx = b.st[1];
        if (nloc == 0u) { xcd_barrier_complete(bar, b.x, nloc, nx); b.st[0] = nloc; b.st[1] = nx; }
        const unsigned old = xb_add(&bar[XB_XSUB(b.x)], 1u);
        const unsigned gen = old / nloc;
        if (old + 1u == (gen + 1u) * nloc) {
            __builtin_amdgcn_fence(__ATOMIC_RELEASE, "agent");
            asm volatile("s_waitcnt vmcnt(0)" ::: "memory");
            const unsigned og = xb_add(&bar[XB_TOP], 1u);
            const unsigned tg = og / nx;
            if (og + 1u == (tg + 1u) * nx) xb_add(&bar[XB_TOPGEN], 1u);
            else XB_SPIN(xb_ld(&bar[XB_TOPGEN]) == tg, bar);
            __builtin_amdgcn_fence(__ATOMIC_ACQUIRE, "agent");
            xb_add(&bar[XB_XGEN(b.x)], 1u);
            asm volatile("s_waitcnt vmcnt(0)" ::: "memory");
        } else {
            XB_SPIN(xb_ld(&bar[XB_XGEN(b.x)]) == gen, bar);
            __builtin_amdgcn_fence(__ATOMIC_ACQUIRE, "agent");
            asm volatile("s_waitcnt vmcnt(0)" ::: "memory");
        }
    }
    __syncthreads();
}

namespace pg8 {
constexpr int BM = 256, BK = 64, HALF = 128, HTB = HALF * BK * 2, STAGE_BYTES = 8 * HTB, NXCD = 8, WGM = 8;
__device__ __forceinline__ int lds_byte(int r, int c) { const int st = (r >> 4) * 2 + (c >> 5), rr = r & 15, cc = c & 31, ob = rr * 64 + cc * 2; return st * 1024 + (ob ^ (((ob >> 9) & 1) << 5)); }
__device__ __forceinline__ void stage_rc(int b, int& R, int& C) { const int st = b / 1024, sb = b % 1024, swz = sb ^ (((sb >> 9) & 1) << 5); R = (st >> 1) * 16 + swz / 64; C = (st & 1) * 32 + (swz % 64) / 2; }
__device__ __forceinline__ int perm32(int rho) { const int n = rho >> 4, i = rho & 15; return 8 * (i >> 2) + 4 * n + (i & 3); }

struct Unit { int pm, pn, acol, ord; };
struct Gemm { const bf16_t* A; const bf16_t* Bt; int lda, K; };

struct StaticOrder {
    int nM, nN, nwg, G, c;
    __device__ void init(int M, int N, int G_, int c_) { nM = M / BM; nN = N / BM; nwg = nM * nN; G = G_; c = c_; }
    __device__ bool next(int i, Unit& u) const {
        const long L = (long)i * G + c; if (L >= nwg) return false;
        int wgid = (int)L; { const int q = nwg / NXCD, r = nwg % NXCD, xcd = wgid % NXCD, off = wgid / NXCD; wgid = (xcd < r ? xcd * (q + 1) : r * (q + 1) + (xcd - r) * q) + off; }
        const int nig = WGM * nN, gid = wgid / nig, fm = gid * WGM, gsz = (nM - fm) < WGM ? (nM - fm) : WGM;
        u.pm = fm + ((wgid % nig) % gsz); u.pn = (wgid % nig) / gsz; u.acol = 0; u.ord = i; return true;
    }
};
struct MergeOrder {
    StaticOrder so;
    __device__ void init(int G_, int c_) { so.init(NTOK, DM, G_, c_); }
    __device__ bool next(int i, Unit& u) const { Unit b; if (!so.next(i >> 2, b)) return false; const int sub = i & 3; u.pm = b.pm; u.pn = sub * 4 + b.pn; u.acol = sub * 512; u.ord = i; return true; }
};

template <class Epi, class Sched, bool ALIGN_EPI = GEMM_ALIGN, bool SP2 = GEMM_SP2>
__device__ __forceinline__ void gemm_phase(lptr lds, const Gemm g, const Sched& S, const Epi& E) {
    int tid_ = threadIdx.x; asm volatile("" : "+v"(tid_)); const int tid = tid_, wid = __builtin_amdgcn_readfirstlane(tid >> 6), lane = tid & 63, wr = wid >> 2, wc = wid & 3, fr = lane & 15, fq = lane >> 4;
    const int K = g.K, nt = K / BK, lda = g.lda;
    unsigned voffA[2], voffB[2];
#pragma unroll
    for (int i = 0; i < 2; ++i) { int R, C; stage_rc(tid * 16 + i * 8192, R, C); const int Rb = Epi::PERM ? ((R & ~31) + perm32(R & 31)) : R;
        voffA[i] = (unsigned)(R * lda + C) * 2u; voffB[i] = (unsigned)(Rb * K + C) * 2u; }
    const size_t kstep = (size_t)(BK * 2);
    const size_t hstepA = (size_t)HALF * lda * 2, tstepA = 2 * hstepA;
    const size_t hstepB = (size_t)HALF * K * 2, tstepB = 2 * hstepB;
    const unsigned ldsw = (unsigned)wid * 1024u;
    const int aoff = lds_byte(wr * 64 + fr, fq * 8), boff = lds_byte(wc * 32 + fr, fq * 8);
#define PG8_SA(b, h) (((b) * 2 + (h)) * HTB)
#define PG8_SB(b, h) ((4 + (b) * 2 + (h)) * HTB)
#define PG8_STAGE(bufoff, gbase, voff) do { _Pragma("unroll") for (int _i = 0; _i < 2; ++_i) \
        __builtin_amdgcn_global_load_lds((const unsigned*)((const char*)(gbase) + (voff)[_i]), (LAS unsigned*)(lds + (bufoff) + ldsw + _i * 8192), 16, 0, 0); } while (0)
#define PG8_LDA(dst, b, h) do { _Pragma("unroll") for (int m = 0; m < 4; ++m) _Pragma("unroll") for (int k = 0; k < 2; ++k) dst[m][k] = *(const LAS bf16x8*)(lds + PG8_SA(b, h) + aoff + m * 2048 + k * 1024); } while (0)
#define PG8_LDB(dst, b, h) do { _Pragma("unroll") for (int n = 0; n < 2; ++n) _Pragma("unroll") for (int k = 0; k < 2; ++k) dst[n][k] = *(const LAS bf16x8*)(lds + PG8_SB(b, h) + boff + n * 2048 + k * 1024); } while (0)
#define PG8_MMA(ai, bj, At, Bt) do { __builtin_amdgcn_s_setprio(1); _Pragma("unroll") for (int m = 0; m < 4; ++m) _Pragma("unroll") for (int n = 0; n < 2; ++n) _Pragma("unroll") for (int k = 0; k < 2; ++k) \
        acc[ai][bj][m][n] = __builtin_amdgcn_mfma_f32_16x16x32_bf16(Bt[n][k], At[m][k], acc[ai][bj][m][n], 0, 0, 0); __builtin_amdgcn_s_setprio(0); } while (0)
#define PG8_WAIT_V(n) asm volatile("s_waitcnt vmcnt(" #n ")" ::: "memory")
#define PG8_WAIT_L(n) asm volatile("s_waitcnt lgkmcnt(" #n ")" ::: "memory")
#define PG8_BAR __builtin_amdgcn_s_barrier()
#define PG8_SCHED __builtin_amdgcn_sched_barrier(0)
    Unit cur, nxt; int ui = 0;
    if (!S.next(0, cur)) return;
    f32x4 acc[2][2][4][2];
#pragma unroll
    for (int a = 0; a < 2; ++a)
#pragma unroll
        for (int b = 0; b < 2; ++b)
#pragma unroll
            for (int m = 0; m < 4; ++m)
#pragma unroll
                for (int n = 0; n < 2; ++n) acc[a][b][m][n] = (f32x4){0.f, 0.f, 0.f, 0.f};
    bf16x8 At[4][2], B0[2][2], B1[2][2];
    const char* cA = (const char*)g.A + (size_t)cur.pm * tstepA + (size_t)cur.acol * 2; const char* cB = (const char*)g.Bt + (size_t)cur.pn * tstepB;
    if constexpr (SP2) {
        PG8_STAGE(PG8_SB(0, 0), cB, voffB); PG8_STAGE(PG8_SB(0, 1), cB + hstepB, voffB); PG8_STAGE(PG8_SA(0, 0), cA, voffA); PG8_STAGE(PG8_SA(0, 1), cA + hstepA, voffA);
        if (wr == 1) PG8_BAR;
        PG8_WAIT_V(2); PG8_BAR;
        PG8_STAGE(PG8_SB(1, 0), cB + kstep, voffB); PG8_STAGE(PG8_SA(1, 0), cA + kstep, voffA); PG8_STAGE(PG8_SB(1, 1), cB + hstepB + kstep, voffB);
        PG8_WAIT_V(6); PG8_BAR;
    } else {
    PG8_STAGE(PG8_SB(0, 0), cB, voffB); PG8_STAGE(PG8_SA(0, 0), cA, voffA); PG8_STAGE(PG8_SB(0, 1), cB + hstepB, voffB); PG8_STAGE(PG8_SA(0, 1), cA + hstepA, voffA);
    if (wr == 1) PG8_BAR;
    PG8_WAIT_V(4); PG8_BAR;
    PG8_STAGE(PG8_SB(1, 0), cB + kstep, voffB); PG8_STAGE(PG8_SA(1, 0), cA + kstep, voffA); PG8_STAGE(PG8_SB(1, 1), cB + hstepB + kstep, voffB);
    PG8_WAIT_V(6); PG8_BAR;
    }
    for (;;) {
        const bool has_next = S.next(ui + 1, nxt);
        const char* nA = has_next ? (const char*)g.A + (size_t)nxt.pm * tstepA + (size_t)nxt.acol * 2 : cA; const char* nB = has_next ? (const char*)g.Bt + (size_t)nxt.pn * tstepB : cB;
        for (int t = 0; t < nt; t += 2) {
            const bool last = (t == nt - 2);
            const char* a1 = cA + (size_t)(t + 1) * kstep;
            const char* a2 = last ? nA : cA + (size_t)(t + 2) * kstep; const char* b2 = last ? nB : cB + (size_t)(t + 2) * kstep;
            const char* a3 = a2 + kstep; const char* b3 = b2 + kstep;
            if constexpr (SP2) {
            PG8_LDB(B0, 0, 0); PG8_LDB(B1, 0, 1); PG8_SCHED; PG8_LDA(At, 0, 0); PG8_STAGE(PG8_SA(1, 1), a1 + hstepA, voffA);
            PG8_WAIT_V(8); PG8_WAIT_L(0); PG8_BAR; PG8_MMA(0, 0, At, B0); PG8_MMA(0, 1, At, B1); PG8_BAR; PG8_SCHED;
            PG8_LDA(At, 0, 1); PG8_STAGE(PG8_SB(0, 0), b2, voffB); PG8_STAGE(PG8_SB(0, 1), b2 + hstepB, voffB); PG8_STAGE(PG8_SA(0, 0), a2, voffA);
            PG8_WAIT_V(8); PG8_WAIT_L(0); PG8_BAR; PG8_MMA(1, 0, At, B0); PG8_MMA(1, 1, At, B1); PG8_BAR; PG8_SCHED;
            PG8_LDB(B0, 1, 0); PG8_LDB(B1, 1, 1); PG8_SCHED; PG8_LDA(At, 1, 0); PG8_STAGE(PG8_SA(0, 1), a2 + hstepA, voffA);
            PG8_WAIT_V(8); PG8_WAIT_L(0); PG8_BAR; PG8_MMA(0, 0, At, B0); PG8_MMA(0, 1, At, B1); PG8_BAR; PG8_SCHED;
            PG8_LDA(At, 1, 1); PG8_STAGE(PG8_SB(1, 0), b3, voffB); PG8_STAGE(PG8_SB(1, 1), b3 + hstepB, voffB); PG8_STAGE(PG8_SA(1, 0), a3, voffA);
            PG8_WAIT_V(8); PG8_WAIT_L(0); PG8_BAR; PG8_MMA(1, 0, At, B0); PG8_MMA(1, 1, At, B1); PG8_BAR; PG8_SCHED;
            } else {
            PG8_LDB(B0, 0, 0); PG8_SCHED; PG8_LDA(At, 0, 0); PG8_STAGE(PG8_SA(1, 1), a1 + hstepA, voffA);
            PG8_WAIT_L(8); PG8_BAR; PG8_WAIT_L(0); PG8_MMA(0, 0, At, B0); PG8_BAR; PG8_SCHED;
            PG8_LDB(B1, 0, 1); PG8_STAGE(PG8_SB(0, 0), b2, voffB);
            PG8_BAR; PG8_WAIT_L(0); PG8_MMA(0, 1, At, B1); PG8_BAR;
            PG8_LDA(At, 0, 1); PG8_STAGE(PG8_SA(0, 0), a2, voffA);
            PG8_BAR; PG8_WAIT_L(0); PG8_MMA(1, 0, At, B0); PG8_BAR; PG8_SCHED;
            PG8_STAGE(PG8_SB(0, 1), b2 + hstepB, voffB);
            PG8_WAIT_V(6); PG8_BAR; PG8_MMA(1, 1, At, B1); PG8_BAR;
            PG8_LDB(B0, 1, 0); PG8_SCHED; PG8_LDA(At, 1, 0); PG8_STAGE(PG8_SA(0, 1), a2 + hstepA, voffA);
            PG8_WAIT_L(8); PG8_BAR; PG8_WAIT_L(0); PG8_MMA(0, 0, At, B0); PG8_BAR; PG8_SCHED;
            PG8_LDB(B1, 1, 1); PG8_STAGE(PG8_SB(1, 0), b3, voffB);
            PG8_BAR; PG8_WAIT_L(0); PG8_MMA(0, 1, At, B1); PG8_BAR;
            PG8_LDA(At, 1, 1); PG8_STAGE(PG8_SA(1, 0), a3, voffA);
            PG8_BAR; PG8_WAIT_L(0); PG8_MMA(1, 0, At, B0); PG8_BAR; PG8_SCHED;
            PG8_STAGE(PG8_SB(1, 1), b3 + hstepB, voffB);
            PG8_WAIT_V(6); PG8_BAR; PG8_MMA(1, 1, At, B1); PG8_BAR;
            }
        }
        if constexpr (ALIGN_EPI) { if (wr == 0) PG8_BAR; }
        bool zero_acc = true;
        if constexpr (Epi::CHAIN) zero_acc = E.chain(acc, cur, wr, wc, fr, fq); else E(acc, cur, wr, wc, fr, fq);
        if (!has_next) break;
        if (zero_acc)
#pragma unroll
        for (int a = 0; a < 2; ++a)
#pragma unroll
            for (int b = 0; b < 2; ++b)
#pragma unroll
                for (int m = 0; m < 4; ++m)
#pragma unroll
                    for (int n = 0; n < 2; ++n) acc[a][b][m][n] = (f32x4){0.f, 0.f, 0.f, 0.f};
        cur = nxt; cA = nA; cB = nB; ++ui;
        if constexpr (ALIGN_EPI) { if (wr == 1) PG8_BAR; }
    }
    PG8_WAIT_V(0);
    if constexpr (!ALIGN_EPI) { if (wr == 0) PG8_BAR; }
    PG8_BAR;
#undef PG8_SA
#undef PG8_SB
#undef PG8_STAGE
#undef PG8_LDA
#undef PG8_LDB
#undef PG8_MMA
#undef PG8_WAIT_V
#undef PG8_WAIT_L
#undef PG8_BAR
#undef PG8_SCHED
}

__device__ __forceinline__ float row_rstd(const float* rowsq, size_t row) {
    const f32x4* q = (const f32x4*)(rowsq + row * 16); const f32x4 a = q[0], b = q[1], c = q[2], d = q[3];
    const float s = ((a[0] + a[1]) + (a[2] + a[3])) + ((b[0] + b[1]) + (b[2] + b[3])) + ((c[0] + c[1]) + (c[2] + c[3])) + ((d[0] + d[1]) + (d[2] + d[3]));
    return rsqrtf(s * (1.f / DM) + EPS);
}
struct EpiResid {
    static constexpr bool PERM = false, CHAIN = false;
    const float* xin; float* out; float scale; bf16_t* xq; const float* gnext; float* rowsq;
    __device__ __forceinline__ void operator()(const f32x4 (&acc)[2][2][4][2], const Unit& u, int wr, int wc, int fr, int fq) const {
        const int row0 = u.pm * BM + wr * 64 + fr, col0 = u.pn * BM + wc * 32 + 4 * fq;
        f32x4 gv[2][2];
#pragma unroll
        for (int bj = 0; bj < 2; ++bj)
#pragma unroll
            for (int n = 0; n < 2; ++n) gv[bj][n] = *(const f32x4*)(gnext + col0 + bj * HALF + n * 16);
#pragma unroll
        for (int ai = 0; ai < 2; ++ai)
#pragma unroll
            for (int mp = 0; mp < 2; ++mp) { f32x4 xv[2][2][2];
#pragma unroll
                for (int mm = 0; mm < 2; ++mm)
#pragma unroll
                    for (int bj = 0; bj < 2; ++bj)
#pragma unroll
                        for (int n = 0; n < 2; ++n) xv[mm][bj][n] = *(const f32x4*)(xin + (size_t)(row0 + ai * HALF + (mp * 2 + mm) * 16) * DM + col0 + bj * HALF + n * 16);
#pragma unroll
                for (int mm = 0; mm < 2; ++mm) { const int m = mp * 2 + mm; const int row = row0 + ai * HALF + m * 16; const size_t off = (size_t)row * DM + col0; float ss = 0.f;
#pragma unroll
                    for (int bj = 0; bj < 2; ++bj)
#pragma unroll
                        for (int n = 0; n < 2; ++n) { const f32x4 v = xv[mm][bj][n] + acc[ai][bj][m][n] * scale; *(f32x4*)(out + off + bj * HALF + n * 16) = v;
                            if (xq) { ss += (v[0] * v[0] + v[1] * v[1]) + (v[2] * v[2] + v[3] * v[3]); const f32x4 q = v * gv[bj][n]; u32x2 w; w.x = pk2(q[0], q[1]); w.y = pk2(q[2], q[3]); *(u32x2*)(xq + off + bj * HALF + n * 16) = w; } }
                    if (xq) { ss += __shfl_xor(ss, 16); ss += __shfl_xor(ss, 32); if (fq == 0) rowsq[(size_t)row * 16 + u.pn * 4 + wc] = ss; } } }
    }
};
struct EpiSwiglu {
    static constexpr bool PERM = true, CHAIN = false;
    bf16_t* hid; const LAS float* rst;
    __device__ __forceinline__ void operator()(const f32x4 (&acc)[2][2][4][2], const Unit& u, int wr, int wc, int fr, int fq) const {
        const int row0 = u.pm * BM + wr * 64 + fr, col0 = u.pn * 128 + wc * 32 + 8 * fq;
        float rsv[2][4];
#pragma unroll
        for (int ai = 0; ai < 2; ++ai)
#pragma unroll
            for (int m = 0; m < 4; ++m) rsv[ai][m] = rst[u.ord * 256 + wr * 64 + fr + ai * HALF + m * 16];
#pragma unroll
        for (int ai = 0; ai < 2; ++ai)
#pragma unroll
            for (int m = 0; m < 4; ++m) { float o[8]; const float rs = rsv[ai][m];
#pragma unroll
                for (int n = 0; n < 2; ++n)
#pragma unroll
                    for (int j = 0; j < 4; ++j) o[n * 4 + j] = siluf_(acc[ai][0][m][n][j] * rs) * (acc[ai][1][m][n][j] * rs);
                *(u32x4*)(hid + (size_t)(row0 + ai * HALF + m * 16) * FF + col0) = pack8(o); }
    }
};
struct EpiInproj {
    static constexpr bool PERM = true, CHAIN = false;
    bf16_t* proj; unsigned char* gates; const LAS float* rst;
    __device__ __forceinline__ void operator()(const f32x4 (&acc)[2][2][4][2], const Unit& u, int wr, int wc, int fr, int fq) const {
        const int row0 = u.pm * BM + wr * 64 + fr;
        const int mode = u.pn < 4 ? 0 : (u.pn < 20 ? 1 : 2);
        float rsv[2][4];
#pragma unroll
        for (int ai = 0; ai < 2; ++ai)
#pragma unroll
            for (int m = 0; m < 4; ++m) rsv[ai][m] = rst[u.ord * 256 + wr * 64 + fr + ai * HALF + m * 16];
#pragma unroll
        for (int ai = 0; ai < 2; ++ai)
#pragma unroll
            for (int m = 0; m < 4; ++m) { const size_t row = (size_t)(row0 + ai * HALF + m * 16); const float rs = rsv[ai][m];
#pragma unroll
                for (int bj = 0; bj < 2; ++bj) { float o[8];
                    const int c0 = u.pn * BM + bj * HALF + wc * 32 + 8 * fq;
#pragma unroll
                    for (int n = 0; n < 2; ++n)
#pragma unroll
                        for (int j = 0; j < 4; ++j) { const float v = acc[ai][bj][m][n][j] * rs; o[n * 4 + j] = mode == 0 ? gelu_tanh(v) : (mode == 1 ? v : sigmoidf_(v)); }
                    if (mode == 2) { unsigned w0 = 0u, w1 = 0u;
#pragma unroll
                        for (int j = 0; j < 4; ++j) { w0 = __builtin_amdgcn_cvt_pk_u8_f32(fmaxf(o[j] * 255.f, 1.f), j, w0); w1 = __builtin_amdgcn_cvt_pk_u8_f32(fmaxf(o[4 + j] * 255.f, 1.f), j, w1); }
                        u32x2 wv; wv.x = w0; wv.y = w1; *(u32x2*)(gates + row * 4096 + (c0 - 5120)) = wv; }
                    else if (c0 < PLD) *(u32x4*)(proj + row * PLD + c0) = pack8(o); } }
    }
};
__device__ __forceinline__ void unpack_u8x8(u32x2 w, float* f) {
#pragma unroll
    for (int j = 0; j < 4; ++j) { f[j] = (float)((w.x >> (8 * j)) & 0xffu); f[4 + j] = (float)((w.y >> (8 * j)) & 0xffu); }
}
struct EpiMerge {
    static constexpr bool PERM = true, CHAIN = true;
    const unsigned char* gates; bf16_t* merged;
    __device__ __forceinline__ bool chain(f32x4 (&acc)[2][2][4][2], const Unit& u, int wr, int wc, int fr, int fq) const {
        const int row0 = u.pm * BM + wr * 64 + fr; const int bi = u.pn >> 2, nn = u.pn & 3; const bool lastb = bi == 3;
#pragma unroll
        for (int ai = 0; ai < 2; ++ai)
#pragma unroll
            for (int mp = 0; mp < 2; ++mp) { u32x2 g0[2][2], g1[2][2];
#pragma unroll
                for (int mm = 0; mm < 2; ++mm)
#pragma unroll
                    for (int bj = 0; bj < 2; ++bj) { const size_t row = (size_t)(row0 + ai * HALF + (mp * 2 + mm) * 16); const int c0 = nn * BM + bj * HALF + wc * 32 + 8 * fq;
                        g0[mm][bj] = *(const u32x2*)(gates + row * 4096 + bi * 1024 + c0);
                        g1[mm][bj] = lastb ? g0[mm][bj] : *(const u32x2*)(gates + row * 4096 + (bi + 1) * 1024 + c0); }
#pragma unroll
                for (int mm = 0; mm < 2; ++mm)
#pragma unroll
                    for (int bj = 0; bj < 2; ++bj) { const int m = mp * 2 + mm; const size_t row = (size_t)(row0 + ai * HALF + m * 16); const int c0 = nn * BM + bj * HALF + wc * 32 + 8 * fq; float ga[8], gb[8], o[8];
                        unpack_u8x8(g0[mm][bj], ga); unpack_u8x8(g1[mm][bj], gb);
#pragma unroll
                        for (int n = 0; n < 2; ++n)
#pragma unroll
                            for (int j = 0; j < 4; ++j) { const float f = lastb ? ga[n * 4 + j] * (1.f / 255.f) : ga[n * 4 + j] * rcpf(gb[n * 4 + j]); const float v = acc[ai][bj][m][n][j] * f; acc[ai][bj][m][n][j] = v; o[n * 4 + j] = v; }
                        if (lastb) *(u32x4*)(merged + row * DM + c0) = pack8(o); } }
        return lastb;
    }
};
}


template <class Sched> __device__ __forceinline__ void rstd_prologue(const Sched& S, const float* rowsq, LAS float* rst) {
    int t_ = threadIdx.x; asm volatile("" : "+v"(t_));
    pg8::Unit u;
    for (int i = 0; i < 12 && S.next(i, u); ++i) if (t_ < 256) rst[i * 256 + t_] = pg8::row_rstd(rowsq, (size_t)u.pm * 256 + t_);
    __syncthreads();
}

template <int MODE> __device__ __forceinline__ int srccol(int n) {
    if (MODE == 0) return n;
    if (MODE == 1) { const int tile = n >> 8, w = n & 255; return w < 128 ? tile * 128 + w : FF + tile * 128 + (w - 128); }
    if (n < 2560) return n;
    if (n < 3840) return n + 8;
    if (n < 4864) return n + 32;
    if (n < 4872) return n - 4864 + 2560;
    if (n < 4896) return n - 4872 + 3848;
    if (n < 5120) return -1;
    return n - 224;
}
template <int MODE>
__device__ __forceinline__ void transpose_item(const float* W, int K, int Nsrc, int Ndst, bf16_t* WT, LAS float* scr, int item, int lane) {
    const int nblk = Ndst / 32, kb = item / nblk, nb = item % nblk, k0 = 64 * kb, n0 = 32 * nb;
    const int sc = srccol<MODE>(n0 + (lane & 31));
#pragma unroll
    for (int i = 0; i < 32; ++i) { const int kk = 2 * i + (lane >> 5); scr[kk * 33 + (lane & 31)] = sc >= 0 ? W[(size_t)(k0 + kk) * Nsrc + sc] : 0.f; }
    asm volatile("s_waitcnt lgkmcnt(0)" ::: "memory");
    const int c = lane & 7;
#pragma unroll
    for (int j = 0; j < 4; ++j) { const int n = (lane >> 3) + 8 * j; const LAS float* s = scr + (8 * c) * 33 + n;
        u32x4 o; o.x = pk2(s[0 * 33], s[1 * 33]); o.y = pk2(s[2 * 33], s[3 * 33]); o.z = pk2(s[4 * 33], s[5 * 33]); o.w = pk2(s[6 * 33], s[7 * 33]);
        *(u32x4*)(WT + (size_t)(n0 + n) * K + k0 + 8 * c) = o; }
    asm volatile("s_waitcnt lgkmcnt(0)" ::: "memory");
}
constexpr int CV_I0 = 16 * 176, CV_I1 = 44 * 32, CV_I2 = 16 * 288, CV_I3 = 8 * 32, CV_I7 = 16 * 32, CV_I10 = 32 * 4, CV_I12 = 2 * 2;
constexpr int CV_NA = CV_I0 + CV_I1 + CV_I2 + 2 * CV_I10 + 2 * CV_I12;
constexpr int CV_NB = CV_I0 + CV_I1 + 4 * CV_I3 + CV_I7;
__device__ __forceinline__ void convert_item_A(const Params& p, int l, int r, LAS float* scr, int lane) {
    unsigned char* ws = p.ws;
    if (r < CV_I0) { transpose_item<1>(p.in[I_F1WI] + (size_t)l * DM * NFF, DM, NFF, NFF, (bf16_t*)(ws + WS_W1IN), scr, r, lane); return; } r -= CV_I0;
    if (r < CV_I2) { transpose_item<2>(p.in[I_WIN] + (size_t)l * DM * 8992, DM, 8992, NIN, (bf16_t*)(ws + WS_WIN), scr, r, lane); return; } r -= CV_I2;
    if (r < CV_I1) { transpose_item<0>(p.in[I_F1WO] + (size_t)l * FF * DM, FF, DM, DM, (bf16_t*)(ws + WS_W1OUT), scr, r, lane); return; } r -= CV_I1;
    if (r < CV_I10) { transpose_item<0>(p.in[I_W1K] + (size_t)l * 2048 * 128, 2048, 128, 128, (bf16_t*)(ws + WS_WC1K), scr, r, lane); return; } r -= CV_I10;
    if (r < CV_I10) { transpose_item<0>(p.in[I_W1V] + (size_t)l * 2048 * 128, 2048, 128, 128, (bf16_t*)(ws + WS_WC1V), scr, r, lane); return; } r -= CV_I10;
    if (r < CV_I12) { transpose_item<0>(p.in[I_W2K] + (size_t)l * 128 * 64, 128, 64, 64, (bf16_t*)(ws + WS_WC2K), scr, r, lane); return; } r -= CV_I12;
    transpose_item<0>(p.in[I_W2V] + (size_t)l * 128 * 64, 128, 64, 64, (bf16_t*)(ws + WS_WC2V), scr, r, lane);
}
__device__ __forceinline__ void convert_item_B(const Params& p, int l, int r, LAS float* scr, int lane) {
    unsigned char* ws = p.ws;
    if (r < CV_I0) { transpose_item<1>(p.in[I_F2WI] + (size_t)l * DM * NFF, DM, NFF, NFF, (bf16_t*)(ws + WS_W2IN), scr, r, lane); return; } r -= CV_I0;
    if (r < CV_I1) { transpose_item<0>(p.in[I_F2WO] + (size_t)l * FF * DM, FF, DM, DM, (bf16_t*)(ws + WS_W2OUT), scr, r, lane); return; } r -= CV_I1;
    if (r < 4 * CV_I3) { const int bi = r / CV_I3; transpose_item<0>(p.in[I_WBR] + ((size_t)l * 4 + bi) * 512 * DM, 512, DM, DM, (bf16_t*)(ws + WS_WB) + (size_t)bi * DM * 512, scr, r % CV_I3, lane); return; } r -= 4 * CV_I3;
    transpose_item<0>(p.in[I_WOUT] + (size_t)l * DM * DM, DM, DM, DM, (bf16_t*)(ws + WS_WO), scr, r, lane);
}
__device__ __forceinline__ void convert_phase(const Params& p, int l, lptr lds) {
    int tid_ = threadIdx.x; asm volatile("" : "+v"(tid_)); const int wave = tid_ >> 6, lane = tid_ & 63;
    LAS float* scr = (LAS float*)(lds + wave * 16384);
    const int gw = blockIdx.x * 8 + wave, NGW = gridDim.x * 8;
    for (int it = gw; it < CV_NA; it += NGW) convert_item_A(p, l, it, scr, lane);
}
__device__ __forceinline__ void convert_wg_item(const Params& p, int l, int r2, lptr lds) {
    int tid_ = threadIdx.x; asm volatile("" : "+v"(tid_)); const int wave = tid_ >> 6, lane = tid_ & 63;
    LAS float* scr = (LAS float*)(lds + wave * 16384);
    constexpr int NB_WG = (CV_NB + 31) / 32;
#pragma unroll 1
    for (int k = 0; k < 4; ++k) {
        if (r2 < NB_WG) { const int w = r2 * 32 + k * 8 + wave; if (w < CV_NB) convert_item_B(p, l, w, scr, lane); }
        else { const int w = (r2 - NB_WG) * 32 + k * 8 + wave; if (w < CV_NA) convert_item_A(p, l + 1, w, scr, lane); } }
    __syncthreads();
}
__device__ __forceinline__ void norm_phase(const float* x, const float* g, bf16_t* xn, float* rowsq) {
    int tid_ = threadIdx.x; asm volatile("" : "+v"(tid_)); const int wave = tid_ >> 6, lane = tid_ & 63;
    const int gw = blockIdx.x * 8 + wave, NGW = gridDim.x * 8;
    f32x4 gv[4];
#pragma unroll
    for (int j = 0; j < 4; ++j) gv[j] = *((const f32x4*)g + lane + 64 * j);
    for (int m = gw; m < NTOK; m += NGW) {
        const f32x4* xr = (const f32x4*)(x + (size_t)m * DM) + lane;
        f32x4 v[4]; float s = 0.f;
#pragma unroll
        for (int j = 0; j < 4; ++j) { v[j] = xr[64 * j]; s += (v[j].x * v[j].x + v[j].y * v[j].y) + (v[j].z * v[j].z + v[j].w * v[j].w); }
        s = wave_sum(s); if (lane < 16) rowsq[(size_t)m * 16 + lane] = lane == 0 ? s : 0.f;
        u32x2* o8 = (u32x2*)(xn + (size_t)m * DM) + lane;
#pragma unroll
        for (int j = 0; j < 4; ++j) { u32x2 w; w.x = pk2(v[j].x * gv[j].x, v[j].y * gv[j].y); w.y = pk2(v[j].z * gv[j].z, v[j].w * gv[j].w); o8[64 * j] = w; }
    }
}
__device__ __forceinline__ void zero_rows(float* r) { int t_ = threadIdx.x; asm volatile("" : "+v"(t_)); for (int i = blockIdx.x * NT + t_; i < NTOK; i += gridDim.x * NT) r[i] = 0.f; }

__device__ __forceinline__ void qknorm_pass(bf16_t* proj, const float* qn, const float* kn) {
    int tid_ = threadIdx.x; asm volatile("" : "+v"(tid_));
    for (int idx = blockIdx.x * NT + tid_; idx < NTOK * 12; idx += gridDim.x * NT) {
        const int tok = idx / 12, v = idx % 12;
        const int col = v < 8 ? C_Q + v * 64 : (v < 10 ? C_KS + (v - 8) * 64 : C_KW + (v - 10) * 64);
        const float* w = v < 8 ? qn : kn; const float sc = v < 8 ? 0.125f * 1.4426950408889634f : 1.0f;
        u32x4* ptr = (u32x4*)(proj + (size_t)tok * PLD + col);
        u32x4 raw[8]; float ss = 0.f;
#pragma unroll
        for (int j = 0; j < 8; ++j) { raw[j] = ptr[j]; float f[8]; unpack8(raw[j], f);
#pragma unroll
            for (int e = 0; e < 8; ++e) ss += f[e] * f[e]; }
        const float r = rsqrtf(ss * (1.f / 64.f) + EPS) * sc;
#pragma unroll
        for (int j = 0; j < 8; ++j) { float f[8]; unpack8(raw[j], f);
#pragma unroll
            for (int e = 0; e < 8; ++e) f[e] = f[e] * r * w[j * 8 + e];
            ptr[j] = pack8(f); }
    }
}

__device__ __forceinline__ void sgu_item(const Params& p, int l, int item, lptr lds) {
    int tid_ = threadIdx.x; asm volatile("" : "+v"(tid_)); const int tid = tid_, wave = __builtin_amdgcn_readfirstlane(tid >> 6), lane = tid & 63, fr = lane & 15, fq = lane >> 4;
    const bf16_t* proj = (const bf16_t*)(p.ws + WS_PROJ); bf16_t* ys = (bf16_t*)(p.ws + WS_YS);
    const size_t tok0 = (size_t)item * 128;
    LAS float* rstd = (LAS float*)lds; lptr Ws = lds + 1024, VT = lds + 1024 + 34816;
    const float* vn = p.in[I_SGUVN] + l * 512;
#pragma unroll 8
    for (int rr = 0; rr < 16; ++rr) { const int t = wave * 16 + rr; float f[8]; unpack8(*(const u32x4*)(proj + (tok0 + t) * PLD + C_V + lane * 8), f); float ss = 0.f;
#pragma unroll
        for (int e = 0; e < 8; ++e) ss += f[e] * f[e];
        ss = wave_sum(ss); if (lane == 0) rstd[t] = rsqrtf(ss * (1.f / 512.f) + EPS); }
    __syncthreads();
    for (int g = 0; g < 4; ++g) {
        { const int t = tid >> 2, s0 = (tid & 3) * 32; const float* wrow = p.in[I_SGUW] + (((size_t)l * 4 + g) * 128 + t) * 128 + s0;
#pragma unroll
          for (int j = 0; j < 4; ++j) { const f32x4 a = *(const f32x4*)(wrow + j * 8), b = *(const f32x4*)(wrow + j * 8 + 4); float f[8] = {a.x, a.y, a.z, a.w, b.x, b.y, b.z, b.w};
#pragma unroll
              for (int e = 0; e < 8; ++e) if (s0 + j * 8 + e > t) f[e] = 0.f;
              *(LAS u32x4*)(Ws + ((size_t)t * 136 + s0 + j * 8) * 2) = pack8(f); } }
        { const int s = tid >> 2, d0 = (tid & 3) * 32; const float rs = rstd[s];
#pragma unroll
          for (int j = 0; j < 4; ++j) { float f[8]; unpack8(*(const u32x4*)(proj + (tok0 + s) * PLD + C_V + g * 128 + d0 + j * 8), f);
#pragma unroll
              for (int e = 0; e < 8; ++e) f[e] = f[e] * rs * vn[g * 128 + d0 + j * 8 + e];
              *(LAS u32x4*)(VT + ((size_t)s * 144 + d0 + j * 8) * 2) = pack8(f); } }
        __syncthreads();
        u32x2 upre[8];
#pragma unroll
        for (int ni = 0; ni < 8; ++ni) upre[ni] = *(const u32x2*)(proj + (tok0 + wave * 16 + fr) * PLD + C_U + g * 128 + ni * 16 + fq * 4);
        f32x4 acc[8];
#pragma unroll
        for (int ni = 0; ni < 8; ++ni) acc[ni] = (f32x4){0.f, 0.f, 0.f, 0.f};
        const int nks = (wave >> 1) + 1;
        for (int ks = 0; ks < nks; ++ks) { const bf16x8 a = ldfrag2(Ws, (wave * 16 + fr) * 136 + ks * 32 + fq * 4, (wave * 16 + fr) * 136 + ks * 32 + 16 + fq * 4);
#pragma unroll
            for (int ni = 0; ni < 8; ++ni) { const bf16x8 b = ldfrag_tr(VT, 144, ks * 32, ks * 32 + 16, ni * 16, lane); acc[ni] = MF(b, a, acc[ni]); } }
        const int t = wave * 16 + fr; const float bias = p.in[I_SGUB][((size_t)l * 4 + g) * 128 + t];
#pragma unroll
        for (int ni = 0; ni < 8; ++ni) { const int d = g * 128 + ni * 16 + fq * 4; const u32x2 uu = upre[ni];
            u32x2 o; o.x = pk2(lo16(uu.x) * (acc[ni][0] + bias), hi16(uu.x) * (acc[ni][1] + bias)); o.y = pk2(lo16(uu.y) * (acc[ni][2] + bias), hi16(uu.y) * (acc[ni][3] + bias));
            *(u32x2*)(ys + (tok0 + t) * YLD + d) = o; }
        __syncthreads();
    }
}

__device__ __forceinline__ float dt_acs_wave(const bf16_t* proj, size_t tokbase, int h, float dtb, float A, LAS float* dtv, LAS float* acs, int lane) {
    float d[2], a[2];
#pragma unroll
    for (int i = 0; i < 2; ++i) { const float raw = bf2f(proj[(tokbase + 2 * lane + i) * PLD + C_DT + h]) + dtb;
        const float sp = raw > 0.f ? raw + log1pf(__expf(-raw)) : log1pf(__expf(raw)); d[i] = sp; a[i] = sp * A; }
    float s = a[0] + a[1];
#pragma unroll
    for (int o = 1; o < 64; o <<= 1) { const float t = __shfl_up(s, o); if (lane >= o) s += t; }
    dtv[2 * lane] = d[0]; dtv[2 * lane + 1] = d[1]; acs[2 * lane] = s - a[1]; acs[2 * lane + 1] = s;
    return s;
}
struct Conv8 { float w[4][8]; float bias[8]; };
__device__ __forceinline__ void conv8_load(Conv8& c, const float* cw, const float* cb, int ch0) {
#pragma unroll
    for (int k = 0; k < 4; ++k) { const f32x4 a = *(const f32x4*)(cw + k * 1024 + ch0), b = *(const f32x4*)(cw + k * 1024 + ch0 + 4);
        c.w[k][0] = a.x; c.w[k][1] = a.y; c.w[k][2] = a.z; c.w[k][3] = a.w; c.w[k][4] = b.x; c.w[k][5] = b.y; c.w[k][6] = b.z; c.w[k][7] = b.w; }
    const f32x4 a = *(const f32x4*)(cb + ch0), b = *(const f32x4*)(cb + ch0 + 4);
    c.bias[0] = a.x; c.bias[1] = a.y; c.bias[2] = a.z; c.bias[3] = a.w; c.bias[4] = b.x; c.bias[5] = b.y; c.bias[6] = b.z; c.bias[7] = b.w;
}
__device__ __forceinline__ void ldrow8(const bf16_t* projb, int sp, int col, float* f) {
    if (sp < 0) {
#pragma unroll
        for (int e = 0; e < 8; ++e) f[e] = 0.f;
    } else unpack8(*(const u32x4*)(projb + (size_t)sp * PLD + col), f);
}
#define CONV_STEP(cv, x, y) do { _Pragma("unroll") for (int e_ = 0; e_ < 8; ++e_) { \
        const float v_ = cv.bias[e_] + cv.w[0][e_] * x[0][e_] + cv.w[1][e_] * x[1][e_] + cv.w[2][e_] * x[2][e_] + cv.w[3][e_] * x[3][e_]; y[e_] = siluf_(v_); \
        x[0][e_] = x[1][e_]; x[1][e_] = x[2][e_]; x[2][e_] = x[3][e_]; } } while (0)


template <int NTK, class F>
__device__ __forceinline__ void conv_run(const Conv8& cv, const bf16_t* projb, int sp0, int col, F&& f) {
    u32x4 raw[NTK + 3];
#pragma unroll
    for (int i = 0; i < NTK + 3; ++i) { const int sp = sp0 - 3 + i; raw[i] = sp >= 0 ? *(const u32x4*)(projb + (size_t)sp * PLD + col) : (u32x4){0u, 0u, 0u, 0u}; }
    float x[4][8];
    unpack8(raw[0], x[0]); unpack8(raw[1], x[1]); unpack8(raw[2], x[2]);
#pragma unroll
    for (int i = 0; i < NTK; ++i) { unpack8(raw[i + 3], x[3]); float y[8]; CONV_STEP(cv, x, y); f(i, y); }
}

__device__ __forceinline__ void mamba1_item(const Params& p, int l, int item, lptr lds) {
    int tid_ = threadIdx.x; asm volatile("" : "+v"(tid_)); const int tid = tid_, wave = __builtin_amdgcn_readfirstlane(tid >> 6), lane = tid & 63, fr = lane & 15, fq = lane >> 4;
    const int g = item & 1, c = (item >> 1) & 15, b = item >> 5;
    if (c == 15) return;
    const bf16_t* proj = (const bf16_t*)(p.ws + WS_PROJ); const bf16_t* projb = proj + (size_t)b * SEQ * PLD;
    LAS float* dtv = (LAS float*)lds; LAS float* acs = (LAS float*)(lds + 2048); lptr BT = lds + 4096, XdT = lds + 4096 + 36864;
    float* states = (float*)(p.ws + WS_STATES); float* atot = (float*)(p.ws + WS_ATOT);
    if (wave < 4) { const int h = g * 4 + wave; const float A = -__expf(p.in[I_SALOG][l * 8 + h]);
        const float tot = dt_acs_wave(proj, (size_t)b * SEQ + c * 128, h, p.in[I_SDTB][l * 8 + h], A, dtv + wave * 128, acs + wave * 128, lane);
        if (lane == 63) atot[(b * 16 + c) * 8 + h] = tot; }
    __syncthreads();
    if (tid < 384) { const int cgp = tid % 48, seg = tid / 48; const bool isB = cgp < 16; const int j = isB ? 0 : cgp - 16;
        const int ch0 = isB ? 512 + g * 128 + cgp * 8 : g * 256 + j * 8; const int hl = j >> 3, p0 = (j & 7) * 8;
        Conv8 cv; conv8_load(cv, p.in[I_SCW] + (size_t)l * 4096, p.in[I_SCB] + (size_t)l * 1024, ch0);
        const float aend = acs[hl * 128 + 127];
#pragma unroll 1
        for (int hf = 0; hf < 2; ++hf) { const int tb = seg * 16 + hf * 8;
            conv_run<8>(cv, projb, c * 128 + tb, C_XBC + ch0, [&](int i, const float* y) { const int tl = tb + i;
                const float sc = isB ? 1.f : dtv[hl * 128 + tl] * __expf(aend - acs[hl * 128 + tl]); float ys_[8];
#pragma unroll
                for (int e = 0; e < 8; ++e) ys_[e] = y[e] * sc;
                lptr dst = isB ? BT + ((size_t)tl * 144 + cgp * 8) * 2 : XdT + ((size_t)tl * 272 + hl * 64 + p0) * 2; *(LAS u32x4*)dst = pack8(ys_); }); }
    }
    __syncthreads();
    { const int hl = wave >> 1, pib = (wave & 1) * 2; f32x4 acc[2][8];
#pragma unroll
      for (int i = 0; i < 2; ++i)
#pragma unroll
          for (int ni = 0; ni < 8; ++ni) acc[i][ni] = (f32x4){0.f, 0.f, 0.f, 0.f};
#pragma unroll
      for (int ks = 0; ks < 4; ++ks) { bf16x8 a[2];
#pragma unroll
          for (int i = 0; i < 2; ++i) a[i] = ldfrag_tr(XdT, 272, ks * 32, ks * 32 + 16, hl * 64 + (pib + i) * 16, lane);
#pragma unroll
          for (int ni = 0; ni < 8; ++ni) { const bf16x8 bb = ldfrag_tr(BT, 144, ks * 32, ks * 32 + 16, ni * 16, lane);
#pragma unroll
              for (int i = 0; i < 2; ++i) acc[i][ni] = MF(bb, a[i], acc[i][ni]); } }
      float* st = states + (size_t)((b * 16 + c) * 8 + g * 4 + hl) * 8192;
#pragma unroll
      for (int i = 0; i < 2; ++i)
#pragma unroll
          for (int ni = 0; ni < 8; ++ni) *(f32x4*)(st + ((pib + i) * 16 + fr) * 128 + ni * 16 + fq * 4) = acc[i][ni];
    }
    __syncthreads();
}


__device__ __forceinline__ void prefix_phase(const Params& p) {
    int tid_ = threadIdx.x; asm volatile("" : "+v"(tid_));
    const float* states = (const float*)(p.ws + WS_STATES); const float* atot = (const float*)(p.ws + WS_ATOT); bf16_t* sinb = (bf16_t*)(p.ws + WS_SINB);
    for (int idx = blockIdx.x * NT + tid_; idx < 64 * 2048; idx += gridDim.x * NT) {
        const int bh = idx >> 11, e4 = (idx & 2047) * 4, b = bh >> 3, h = bh & 7;
        f32x4 st[15]; float dec[15];
#pragma unroll
        for (int c = 0; c < 15; ++c) { st[c] = *(const f32x4*)(states + (size_t)((b * 16 + c) * 8 + h) * 8192 + e4); dec[c] = atot[(b * 16 + c) * 8 + h]; }
        f32x4 S = (f32x4){0.f, 0.f, 0.f, 0.f};
#pragma unroll
        for (int c = 0; c < 15; ++c) { S = S * __expf(dec[c]) + st[c]; u32x2 o; o.x = pk2(S[0], S[1]); o.y = pk2(S[2], S[3]);
            *(u32x2*)(sinb + (size_t)((b * 16 + c + 1) * 8 + h) * 8192 + e4) = o; }
    }
}

__device__ __forceinline__ void mamba2_item(const Params& p, int l, int item, lptr lds) {
    int tid_ = threadIdx.x; asm volatile("" : "+v"(tid_)); const int tid = tid_, wave = __builtin_amdgcn_readfirstlane(tid >> 6), lane = tid & 63, fr = lane & 15, fq = lane >> 4;
    const int c = item & 15, b = item >> 4;
    const bf16_t* proj = (const bf16_t*)(p.ws + WS_PROJ); const bf16_t* projb = proj + (size_t)b * SEQ * PLD; bf16_t* ys = (bf16_t*)(p.ws + WS_YS);
    const bf16_t* sinb = (const bf16_t*)(p.ws + WS_SINB);
    LAS float* dtv = (LAS float*)lds; LAS float* acs = (LAS float*)(lds + 4096);
    lptr Cs = lds + 8192, Bs = lds + 43008, XT = lds + 77824, Sin = lds + 96256, XN = lds + 113664;
    const size_t tokbase = (size_t)b * SEQ + c * 128;
    { const int h = wave; const float A = -__expf(p.in[I_SALOG][l * 8 + h]); dt_acs_wave(proj, tokbase, h, p.in[I_SDTB][l * 8 + h], A, dtv + h * 128, acs + h * 128, lane); }
    __syncthreads();
    const int l_row = wave * 16 + fr;
    float ssq = 0.f;
#pragma unroll 1
    for (int g = 0; g < 2; ++g) {
        { const int cgp = tid & 31, seg = tid >> 5; const int ch0 = cgp < 16 ? 512 + g * 128 + cgp * 8 : 768 + g * 128 + (cgp - 16) * 8;
          lptr dst = cgp < 16 ? Bs : Cs; const int n0 = (cgp & 15) * 8;
          Conv8 cv; conv8_load(cv, p.in[I_SCW] + (size_t)l * 4096, p.in[I_SCB] + (size_t)l * 1024, ch0);
          conv_run<8>(cv, projb, c * 128 + seg * 8, C_XBC + ch0, [&](int i, const float* y) { *(LAS u32x4*)(dst + ((size_t)(seg * 8 + i) * 136 + n0) * 2) = pack8(y); }); }
        __syncthreads();
#pragma unroll 1
        for (int hl = 0; hl < 4; ++hl) { const int h = g * 4 + hl;
            u32x2 zpre[4];
#pragma unroll
            for (int pi = 0; pi < 4; ++pi) zpre[pi] = *(const u32x2*)(proj + (tokbase + l_row) * PLD + C_Z + h * 64 + pi * 16 + fq * 4);
            if (tid < 256) { const int cgp = tid & 7, seg = tid >> 3; const int ch0 = h * 64 + cgp * 8;
                Conv8 cv; conv8_load(cv, p.in[I_SCW] + (size_t)l * 4096, p.in[I_SCB] + (size_t)l * 1024, ch0);
                conv_run<4>(cv, projb, c * 128 + seg * 4, C_XBC + ch0, [&](int i, const float* y) { const int tl = seg * 4 + i;
                    *(LAS u32x4*)(XN + ((size_t)tl * 72 + cgp * 8) * 2) = pack8(y); const float d = dtv[h * 128 + tl]; float yd[8];
#pragma unroll
                    for (int e = 0; e < 8; ++e) yd[e] = y[e] * d;
                    *(LAS u32x4*)(XT + ((size_t)tl * 72 + cgp * 8) * 2) = pack8(yd); }); }
            if (c > 0) { const bf16_t* sb = sinb + (size_t)((b * 16 + c) * 8 + h) * 8192;
#pragma unroll
                for (int k = 0; k < 2; ++k) { const int idx = tid * 8 + k * 4096, pp = idx >> 7, n = idx & 127; *(LAS u32x4*)(Sin + ((size_t)pp * 136 + n) * 2) = *(const u32x4*)(sb + idx); } }
            __syncthreads();
            f32x4 y[4];
#pragma unroll
            for (int pi = 0; pi < 4; ++pi) y[pi] = (f32x4){0.f, 0.f, 0.f, 0.f};
            const float al = acs[h * 128 + l_row];
            bf16x8 aC[4];
#pragma unroll
            for (int ks = 0; ks < 4; ++ks) aC[ks] = ldfrag(Cs, (wave * 16 + fr) * 136 + ks * 32 + fq * 8);
            if (c > 0) {
#pragma unroll
                for (int ks = 0; ks < 4; ++ks) {
#pragma unroll
                    for (int pi = 0; pi < 4; ++pi) { const bf16x8 bb = ldfrag(Sin, (pi * 16 + fr) * 136 + ks * 32 + fq * 8); y[pi] = MF(bb, aC[ks], y[pi]); } }
                const float ea = __expf(al);
#pragma unroll
                for (int pi = 0; pi < 4; ++pi) y[pi] *= ea; }
#pragma unroll 1
            for (int ks2 = 0; 2 * ks2 <= wave; ++ks2) {
                f32x4 cb0 = (f32x4){0.f, 0.f, 0.f, 0.f}, cb1 = (f32x4){0.f, 0.f, 0.f, 0.f};
#pragma unroll
                for (int ks = 0; ks < 4; ++ks) { const bf16x8 b0 = ldfrag(Bs, ((2 * ks2) * 16 + fr) * 136 + ks * 32 + fq * 8), b1 = ldfrag(Bs, ((2 * ks2 + 1) * 16 + fr) * 136 + ks * 32 + fq * 8);
                    cb0 = MF(b0, aC[ks], cb0); cb1 = MF(b1, aC[ks], cb1); }
                const f32x4 a0 = *(const LAS f32x4*)(acs + h * 128 + (2 * ks2) * 16 + fq * 4), a1 = *(const LAS f32x4*)(acs + h * 128 + (2 * ks2 + 1) * 16 + fq * 4);
                f32x4 t0, t1;
#pragma unroll
                for (int j = 0; j < 4; ++j) { const int s0 = (2 * ks2) * 16 + fq * 4 + j, s1 = s0 + 16;
                    t0[j] = s0 <= l_row ? cb0[j] * __expf(fminf(al - a0[j], 0.f)) : 0.f;
                    t1[j] = s1 <= l_row ? cb1[j] * __expf(fminf(al - a1[j], 0.f)) : 0.f; }
                const bf16x8 pa = packfrag(t0, t1);
#pragma unroll
                for (int pi = 0; pi < 4; ++pi) { const bf16x8 bb = ldfrag_tr(XT, 72, (2 * ks2) * 16, (2 * ks2 + 1) * 16, pi * 16, lane); y[pi] = MF(bb, pa, y[pi]); } }
            const float Dh = p.in[I_SD][l * 8 + h];
#pragma unroll
            for (int pi = 0; pi < 4; ++pi) { const int pc = pi * 16 + fq * 4; const u32x2 xr = *(const LAS u32x2*)(XN + ((size_t)l_row * 72 + pc) * 2);
                const u32x2 zr = zpre[pi];
                const float xs4[4] = {lo16(xr.x), hi16(xr.x), lo16(xr.y), hi16(xr.y)}, z4[4] = {lo16(zr.x), hi16(zr.x), lo16(zr.y), hi16(zr.y)}; float o[4];
#pragma unroll
                for (int j = 0; j < 4; ++j) { o[j] = (y[pi][j] + xs4[j] * Dh) * siluf_(z4[j]); ssq += o[j] * o[j]; }
                u32x2 ov; ov.x = pk2(o[0], o[1]); ov.y = pk2(o[2], o[3]);
                *(u32x2*)(ys + (tokbase + l_row) * YLD + 512 + h * 64 + pc) = ov; }
            __syncthreads();
        }
    }
    ssq += __shfl_xor(ssq, 16); ssq += __shfl_xor(ssq, 32);
    const float rs = rsqrtf(ssq * (1.f / 512.f) + EPS);
    const float* ng = p.in[I_SNORM] + l * 512;
#pragma unroll 1
    for (int h = 0; h < 8; ++h)
#pragma unroll
        for (int pi = 0; pi < 4; ++pi) { const int col = h * 64 + pi * 16 + fq * 4; u32x2* ptr = (u32x2*)(ys + (tokbase + l_row) * YLD + 512 + col); const u32x2 r = *ptr; const f32x4 gg = *(const f32x4*)(ng + col);
            u32x2 ov; ov.x = pk2(lo16(r.x) * rs * gg.x, hi16(r.x) * rs * gg.y); ov.y = pk2(lo16(r.y) * rs * gg.z, hi16(r.y) * rs * gg.w); *ptr = ov; }
    __syncthreads();
}

__device__ __forceinline__ void compress_item(const Params& p, int l, int item, lptr lds) {
    int tid_ = threadIdx.x; asm volatile("" : "+v"(tid_)); const int tid = tid_, wave = __builtin_amdgcn_readfirstlane(tid >> 6), lane = tid & 63, fr = lane & 15, fq = lane >> 4;
    const int kv = item & 1, half = (item >> 1) & 1, g = (item >> 2) & 1, b = item >> 3;
    const bf16_t* projb = (const bf16_t*)(p.ws + WS_PROJ) + (size_t)b * SEQ * PLD;
    const int col = (kv ? C_VC : C_KC) + g * 64;
    const float* pe = p.in[kv ? I_PEV : I_PEK] + (size_t)l * 2048;
    const bf16_t* w1t = (const bf16_t*)(p.ws + (kv ? WS_WC1V : WS_WC1K)); const bf16_t* w2t = (const bf16_t*)(p.ws + (kv ? WS_WC2V : WS_WC2K));
    bf16_t* kcmp = (bf16_t*)(p.ws + WS_KCMP); bf16_t* vcmpT = (bf16_t*)(p.ws + WS_VCMPT);
    lptr As = lds, Bs = lds + 33792, H1 = lds + 101376, W2s = lds + 118784; LAS float* Of = (LAS float*)lds;
    const int mi = wave >> 1, nib = (wave & 1) * 4;
    f32x4 acc[4];
#pragma unroll
    for (int i = 0; i < 4; ++i) acc[i] = (f32x4){0.f, 0.f, 0.f, 0.f};
    for (int step = 0; step < 8; ++step) {
        { const int r = tid >> 3, q = tid & 7, pp = q >> 1, e0 = (q & 1) * 32; const int cmp = half * 64 + r, pos = 16 * cmp + step * 4 + pp;
#pragma unroll
          for (int j = 0; j < 4; ++j) { float f[8];
              if (pos < SEQ) unpack8(*(const u32x4*)(projb + (size_t)pos * PLD + col + e0 + j * 8), f); else {
#pragma unroll
                  for (int e = 0; e < 8; ++e) f[e] = 0.f; }
              const float* pr = pe + (step * 4 + pp) * 64 + e0 + j * 8;
#pragma unroll
              for (int e = 0; e < 8; ++e) f[e] += pr[e];
              *(LAS u32x4*)(As + ((size_t)r * 264 + pp * 64 + e0 + j * 8) * 2) = pack8(f); } }
        { const int jrow = tid >> 2, k0 = (tid & 3) * 64;
#pragma unroll
          for (int j = 0; j < 8; ++j) *(LAS u32x4*)(Bs + ((size_t)jrow * 264 + k0 + j * 8) * 2) = *(const u32x4*)(w1t + (size_t)jrow * 2048 + step * 256 + k0 + j * 8); }
        __syncthreads();
#pragma unroll
        for (int ks = 0; ks < 8; ++ks) { const bf16x8 a = ldfrag(As, (mi * 16 + fr) * 264 + ks * 32 + fq * 8);
#pragma unroll
            for (int i = 0; i < 4; ++i) { const bf16x8 bb = ldfrag(Bs, ((nib + i) * 16 + fr) * 264 + ks * 32 + fq * 8); acc[i] = MF(bb, a, acc[i]); } }
        __syncthreads();
    }
#pragma unroll
    for (int i = 0; i < 4; ++i) { const int r = mi * 16 + fr, j0 = (nib + i) * 16 + fq * 4; u32x2 o; o.x = pk2(gelu_tanh(acc[i][0]), gelu_tanh(acc[i][1])); o.y = pk2(gelu_tanh(acc[i][2]), gelu_tanh(acc[i][3]));
        *(LAS u32x2*)(H1 + ((size_t)r * 136 + j0) * 2) = o; }
    { const int e = tid >> 3, k0 = (tid & 7) * 16;
#pragma unroll
      for (int j = 0; j < 2; ++j) *(LAS u32x4*)(W2s + ((size_t)e * 136 + k0 + j * 8) * 2) = *(const u32x4*)(w2t + e * 128 + k0 + j * 8); }
    __syncthreads();
    { const int eib = (wave & 1) * 2; f32x4 a2[2] = {(f32x4){0.f, 0.f, 0.f, 0.f}, (f32x4){0.f, 0.f, 0.f, 0.f}};
#pragma unroll
      for (int ks = 0; ks < 4; ++ks) { const bf16x8 a = ldfrag(H1, (mi * 16 + fr) * 136 + ks * 32 + fq * 8);
#pragma unroll
          for (int i = 0; i < 2; ++i) { const bf16x8 bb = ldfrag(W2s, ((eib + i) * 16 + fr) * 136 + ks * 32 + fq * 8); a2[i] = MF(bb, a, a2[i]); } }
#pragma unroll
      for (int i = 0; i < 2; ++i)
#pragma unroll
          for (int j = 0; j < 4; ++j) Of[(mi * 16 + fr) * 65 + (eib + i) * 16 + fq * 4 + j] = a2[i][j]; }
    __syncthreads();
    { const int r = tid >> 3, e0 = (tid & 7) * 8; const int cmp = half * 64 + r; float f[8]; float ss = 0.f;
#pragma unroll
      for (int e = 0; e < 8; ++e) { f[e] = Of[r * 65 + e0 + e]; ss += f[e] * f[e]; }
      ss += __shfl_xor(ss, 1); ss += __shfl_xor(ss, 2); ss += __shfl_xor(ss, 4);
      if (kv == 0) { const float rs = rsqrtf(ss * (1.f / 64.f) + EPS); const float* kn = p.in[I_KN] + l * 64;
#pragma unroll
          for (int e = 0; e < 8; ++e) f[e] = cmp == 127 ? 0.f : f[e] * rs * kn[e0 + e];
          *(u32x4*)(kcmp + ((size_t)(b * 2 + g) * 128 + cmp) * 64 + e0) = pack8(f); }
      else {
#pragma unroll
          for (int e = 0; e < 8; ++e) vcmpT[((size_t)(b * 2 + g) * 64 + e0 + e) * 128 + cmp] = cmp == 127 ? (bf16_t)0 : f2bf(f[e]); } }
    __syncthreads();
}

template <int KIND>
__device__ __forceinline__ void attn_tile(lptr Ks, lptr VT, lptr Qs, int qrow, const int (&trow)[2], float slope, int j, bool masked, const LAS unsigned* selq,
                                          float (&m)[2], float (&lsum)[2], f32x4 (&O)[2][4], int fr, int fq) {
    f32x4 S[2][4];
    { f32x4 cb0;
#pragma unroll
      for (int jj = 0; jj < 4; ++jj) cb0[jj] = slope * (float)(fq * 4 + jj);
#pragma unroll
      for (int ni = 0; ni < 4; ++ni) { S[0][ni] = cb0 + slope * (float)(64 * j + 16 * ni); S[1][ni] = S[0][ni]; } }
    unsigned selrow[2] = {0u, 0u};
    if (KIND == 1) { selrow[0] = selq[fr]; selrow[1] = selq[16 + fr]; }
#pragma unroll
    for (int ks = 0; ks < 2; ++ks)
    { const bf16x8 q0 = ldfrag(Qs, (qrow + fr) * 72 + ks * 32 + fq * 8), q1 = ldfrag(Qs, (qrow + 16 + fr) * 72 + ks * 32 + fq * 8);
#pragma unroll
        for (int ni = 0; ni < 4; ++ni) { const bf16x8 kf = ldfrag(Ks, (ni * 16 + fr) * 72 + ks * 32 + fq * 8); S[0][ni] = MF(kf, q0, S[0][ni]); S[1][ni] = MF(kf, q1, S[1][ni]); } }
    if (masked) {
#pragma unroll
        for (int mi = 0; mi < 2; ++mi) { const bool rowsel = KIND == 1 ? (((selrow[mi] >> j) & 1u) != 0u) : true;
            const int tl = rowsel ? trow[mi] - 64 * j - fq * 4 : -1;
#pragma unroll
            for (int ni = 0; ni < 4; ++ni)
#pragma unroll
                for (int jj = 0; jj < 4; ++jj) { const bool valid = KIND == 1 ? (ni * 16 + jj <= tl) : ((unsigned)(tl - (ni * 16 + jj)) < 256u); S[mi][ni][jj] = valid ? S[mi][ni][jj] : -1e30f; } }
    } else if (KIND == 1) {
#pragma unroll
        for (int mi = 0; mi < 2; ++mi) { const bool rowsel = ((selrow[mi] >> j) & 1u) != 0u;
#pragma unroll
            for (int ni = 0; ni < 4; ++ni)
#pragma unroll
                for (int jj = 0; jj < 4; ++jj) S[mi][ni][jj] = rowsel ? S[mi][ni][jj] : -1e30f; }
    }
#pragma unroll
    for (int mi = 0; mi < 2; ++mi) { float mx = -1e30f;
#pragma unroll
        for (int ni = 0; ni < 4; ++ni)
#pragma unroll
            for (int jj = 0; jj < 4; ++jj) mx = fmaxf(mx, S[mi][ni][jj]);
        mx = fmaxf(mx, __shfl_xor(mx, 16)); mx = fmaxf(mx, __shfl_xor(mx, 32));
        const float mnew = fmaxf(m[mi], mx); const float alpha = __builtin_amdgcn_exp2f(m[mi] - mnew); const float msub = fmaxf(mnew, -1e29f); float sum = 0.f;
#pragma unroll
        for (int ni = 0; ni < 4; ++ni)
#pragma unroll
            for (int jj = 0; jj < 4; ++jj) { const float pv = __builtin_amdgcn_exp2f(S[mi][ni][jj] - msub); S[mi][ni][jj] = pv; sum += pv; }
        sum += __shfl_xor(sum, 16); sum += __shfl_xor(sum, 32);
        lsum[mi] = lsum[mi] * alpha + sum; m[mi] = mnew;
#pragma unroll
        for (int ei = 0; ei < 4; ++ei) O[mi][ei] *= alpha; }
#pragma unroll
    for (int ks2 = 0; ks2 < 2; ++ks2)
#pragma unroll
        for (int ei = 0; ei < 4; ++ei) { const bf16x8 vf = ldfrag_tr(VT, 72, (2 * ks2) * 16, (2 * ks2 + 1) * 16, ei * 16, fq * 16 + fr);
#pragma unroll
            for (int mi = 0; mi < 2; ++mi) O[mi][ei] = MF(vf, packfrag(S[mi][2 * ks2], S[mi][2 * ks2 + 1]), O[mi][ei]); }
}
__device__ __forceinline__ void kv_load(u32x4& kr, u32x4& vr, const bf16_t* projb, int j, int kcol, int vcol, int tid) {
    const int row = tid >> 3, ch = tid & 7; const bf16_t* src = projb + (size_t)(64 * j + row) * PLD;
    kr = *(const u32x4*)(src + kcol + ch * 8); vr = *(const u32x4*)(src + vcol + ch * 8);
}
__device__ __forceinline__ void kv_store(lptr Ks, lptr VT, const u32x4 kr, const u32x4 vr, int tid) {
    const int row = tid >> 3, ch = tid & 7;
    *(LAS u32x4*)(Ks + ((size_t)row * 72 + ch * 8) * 2) = kr;
    *(LAS u32x4*)(VT + ((size_t)row * 72 + ch * 8) * 2) = vr;
}
__device__ __forceinline__ void nsa_item(const Params& p, int l, int item, lptr lds) {
    int tid_ = threadIdx.x; asm volatile("" : "+v"(tid_)); const int tid = tid_, wave = __builtin_amdgcn_readfirstlane(tid >> 6), lane = tid & 63, fr = lane & 15, fq = lane >> 4;
    const int qt = item & 31, g = (item >> 5) & 1, b = item >> 6; const int t0 = qt * 64, cur = qt;
    const bf16_t* projb = (const bf16_t*)(p.ws + WS_PROJ) + (size_t)b * SEQ * PLD; bf16_t* ys = (bf16_t*)(p.ws + WS_YS);
    const bf16_t* kcmp = (const bf16_t*)(p.ws + WS_KCMP) + (size_t)(b * 2 + g) * 8192; const bf16_t* vcmpT = (const bf16_t*)(p.ws + WS_VCMPT) + (size_t)(b * 2 + g) * 8192;
    lptr Ks = lds, VT = lds + 9216, Ks1 = lds + 125184, VT1 = lds + 134400; LAS float* Pc = (LAS float*)(lds + 18432); LAS unsigned* selm = (LAS unsigned*)(lds + 52224); lptr Kc = lds + 52480, VcT = lds + 70912;
    const int r = wave >> 1, qh = wave & 1, hh = g * 4 + r; const float slope = exp2f(-(float)(hh + 1)) * 1.4426950408889634f;
    int trow[2]; lptr Qs = lds + 88320; const int qrow = wave * 32;
#pragma unroll
    for (int mi = 0; mi < 2; ++mi) { trow[mi] = t0 + qh * 32 + mi * 16 + fr;
#pragma unroll
        for (int ks = 0; ks < 2; ++ks) *(LAS bf16x8*)(Qs + ((size_t)(qrow + mi * 16 + fr) * 72 + ks * 32 + fq * 8) * 2) = *(const bf16x8*)(projb + (size_t)trow[mi] * PLD + C_Q + hh * 64 + ks * 32 + fq * 8);
    }
#define GATE(mi, i) sigmoidf_(bf2f(projb[(size_t)trow[mi] * PLD + C_GATE + hh * 3 + (i)]))
    f32x4 outa[2][4];
#pragma unroll
    for (int k = 0; k < 2; ++k) { const int idx = tid + k * 512;
        { const int row = idx >> 3, ch = idx & 7; *(LAS u32x4*)(Kc + ((size_t)row * 72 + ch * 8) * 2) = *(const u32x4*)(kcmp + row * 64 + ch * 8); }
        { const int row = idx >> 4, ch = idx & 15; *(LAS u32x4*)(VcT + ((size_t)row * 136 + ch * 8) * 2) = *(const u32x4*)(vcmpT + row * 128 + ch * 8); } }
    __syncthreads();
    {
        f32x4 S[2][8];
#pragma unroll
        for (int mi = 0; mi < 2; ++mi)
#pragma unroll
            for (int ni = 0; ni < 8; ++ni) S[mi][ni] = (f32x4){0.f, 0.f, 0.f, 0.f};
#pragma unroll
        for (int ks = 0; ks < 2; ++ks)
#pragma unroll
            for (int ni = 0; ni < 8; ++ni) { const bf16x8 kf = ldfrag(Kc, (ni * 16 + fr) * 72 + ks * 32 + fq * 8);
#pragma unroll
                for (int mi = 0; mi < 2; ++mi) S[mi][ni] = MF(kf, ldfrag(Qs, (qrow + mi * 16 + fr) * 72 + ks * 32 + fq * 8), S[mi][ni]); }
#pragma unroll
        for (int mi = 0; mi < 2; ++mi) { const int t = trow[mi]; float mx = -1e30f;
#pragma unroll
            for (int ni = 0; ni < 8; ++ni)
#pragma unroll
                for (int jj = 0; jj < 4; ++jj) { const int ci = ni * 16 + fq * 4 + jj; const bool valid = (16 * ci + 31 <= t);
                    const float s = valid ? S[mi][ni][jj] - slope * ((float)t - (16.f * (float)ci + 15.5f)) : -1e30f; S[mi][ni][jj] = s; mx = fmaxf(mx, s); }
            mx = fmaxf(mx, __shfl_xor(mx, 16)); mx = fmaxf(mx, __shfl_xor(mx, 32)); float sum = 0.f;
#pragma unroll
            for (int ni = 0; ni < 8; ++ni)
#pragma unroll
                for (int jj = 0; jj < 4; ++jj) { const float s = S[mi][ni][jj]; const float pv = s > -1e29f ? __builtin_amdgcn_exp2f(s - mx) : 0.f; S[mi][ni][jj] = pv; sum += pv; }
            sum += __shfl_xor(sum, 16); sum += __shfl_xor(sum, 32); const float inv = sum > 0.f ? 1.f / sum : 0.f;
#pragma unroll
            for (int ni = 0; ni < 8; ++ni) S[mi][ni] *= inv; }
#pragma unroll 1
        for (int rr = 0; rr < 4; ++rr) {
            if (r == rr) {
#pragma unroll
                for (int mi = 0; mi < 2; ++mi)
#pragma unroll
                    for (int ni = 0; ni < 8; ++ni) { LAS f32x4* dst = (LAS f32x4*)(Pc + (qh * 32 + mi * 16 + fr) * 132 + ni * 16 + fq * 4); if (rr == 0) *dst = S[mi][ni]; else *dst = *dst + S[mi][ni]; } }
            __syncthreads(); }
        bf16x8 pf[2][4];
#pragma unroll
        for (int mi = 0; mi < 2; ++mi)
#pragma unroll
            for (int ks2 = 0; ks2 < 4; ++ks2) pf[mi][ks2] = packfrag(S[mi][2 * ks2], S[mi][2 * ks2 + 1]);
        f32x4 O[2][4];
#pragma unroll
        for (int mi = 0; mi < 2; ++mi)
#pragma unroll
            for (int ei = 0; ei < 4; ++ei) O[mi][ei] = (f32x4){0.f, 0.f, 0.f, 0.f};
#pragma unroll
        for (int ks2 = 0; ks2 < 4; ++ks2)
#pragma unroll
            for (int ei = 0; ei < 4; ++ei) { const bf16x8 vf = ldfrag2(VcT, (ei * 16 + fr) * 136 + (2 * ks2) * 16 + fq * 4, (ei * 16 + fr) * 136 + (2 * ks2 + 1) * 16 + fq * 4);
#pragma unroll
                for (int mi = 0; mi < 2; ++mi) O[mi][ei] = MF(vf, pf[mi][ks2], O[mi][ei]); }
        const float g0v[2] = {GATE(0, 0), GATE(1, 0)};
#pragma unroll
        for (int mi = 0; mi < 2; ++mi)
#pragma unroll
            for (int ei = 0; ei < 4; ++ei) outa[mi][ei] = O[mi][ei] * g0v[mi];
    }
    if (wave == 0) { const int q = lane; const LAS float* pr = Pc + q * 132; float sc[32];
#pragma unroll
        for (int n = 0; n < 32; ++n) { float im = 0.f;
#pragma unroll
            for (int cc = 4 * n - 1; cc <= 4 * n + 3; ++cc) if (cc >= 0 && cc <= 126) im += pr[cc];
            const bool forced = (n == 0) || (n == cur) || (n == cur - 1);
            sc[n] = forced ? 1e9f : (n <= cur ? im : -1e30f); }
        unsigned mask = 0u;
#pragma unroll
        for (int it = 0; it < 8; ++it) { float best = -3e38f; int bi = 0;
#pragma unroll
            for (int n = 0; n < 32; ++n) if (sc[n] > best) { best = sc[n]; bi = n; }
            mask |= 1u << bi;
#pragma unroll
            for (int n = 0; n < 32; ++n) if (n == bi) sc[n] = -3e38f; }
        selm[q] = mask; }
    __syncthreads();
    unsigned U = selm[lane];
#pragma unroll
    for (int o = 32; o >= 1; o >>= 1) U |= __shfl_xor(U, o);
    U = __builtin_amdgcn_readfirstlane(U);
    const LAS unsigned* selq = selm + qh * 32;
    {
        float m[2] = {-1e30f, -1e30f}, ls[2] = {0.f, 0.f}; f32x4 O[2][4];
#pragma unroll
        for (int mi = 0; mi < 2; ++mi)
#pragma unroll
            for (int ei = 0; ei < 4; ++ei) O[mi][ei] = (f32x4){0.f, 0.f, 0.f, 0.f};
        { const unsigned Uv = cur >= 31 ? U : (U & ((2u << cur) - 1u));
          unsigned rem = Uv; int j = __builtin_ctz(rem); rem &= rem - 1u;
          u32x4 kr, vr; kv_load(kr, vr, projb, j, C_KS + g * 64, C_VS + g * 64, tid);
          kv_store(Ks, VT, kr, vr, tid); __syncthreads();
          int jn = rem ? __builtin_ctz(rem) : -1; rem &= rem - 1u;
          if (jn >= 0) kv_load(kr, vr, projb, jn, C_KS + g * 64, C_VS + g * 64, tid);
          int cb = 0;
#pragma unroll 1
          for (;;) {
              int jnn = -1;
              if (jn >= 0) { kv_store(cb ? Ks : Ks1, cb ? VT : VT1, kr, vr, tid); jnn = rem ? __builtin_ctz(rem) : -1; rem &= rem - 1u;
                  if (jnn >= 0) kv_load(kr, vr, projb, jnn, C_KS + g * 64, C_VS + g * 64, tid); }
              attn_tile<1>(cb ? Ks1 : Ks, cb ? VT1 : VT, Qs, qrow, trow, slope, j, true, selq, m, ls, O, fr, fq);
              __syncthreads();
              if (jn < 0) break; j = jn; jn = jnn; cb ^= 1; } }
#pragma unroll
        for (int mi = 0; mi < 2; ++mi) { const float sc = GATE(mi, 1) / ls[mi];
#pragma unroll
            for (int ei = 0; ei < 4; ++ei) outa[mi][ei] += O[mi][ei] * sc; }
    }
    {
        float m[2] = {-1e30f, -1e30f}, ls[2] = {0.f, 0.f}; f32x4 O[2][4];
#pragma unroll
        for (int mi = 0; mi < 2; ++mi)
#pragma unroll
            for (int ei = 0; ei < 4; ++ei) O[mi][ei] = (f32x4){0.f, 0.f, 0.f, 0.f};
        { int j = cur > 4 ? cur - 4 : 0;
          u32x4 kr, vr; kv_load(kr, vr, projb, j, C_KW + g * 64, C_VW + g * 64, tid);
          kv_store(Ks, VT, kr, vr, tid); __syncthreads();
          if (j < cur) kv_load(kr, vr, projb, j + 1, C_KW + g * 64, C_VW + g * 64, tid);
          int cb = 0;
#pragma unroll 1
          for (;;) {
              if (j < cur) { kv_store(cb ? Ks : Ks1, cb ? VT : VT1, kr, vr, tid); if (j + 1 < cur) kv_load(kr, vr, projb, j + 2, C_KW + g * 64, C_VW + g * 64, tid); }
              attn_tile<2>(cb ? Ks1 : Ks, cb ? VT1 : VT, Qs, qrow, trow, slope, j, true, selq, m, ls, O, fr, fq);
              __syncthreads();
              if (j >= cur) break; ++j; cb ^= 1; } }
#pragma unroll
        for (int mi = 0; mi < 2; ++mi) { const float sc = GATE(mi, 2) / ls[mi];
#pragma unroll
            for (int ei = 0; ei < 4; ++ei) outa[mi][ei] += O[mi][ei] * sc; }
    }
#pragma unroll
    for (int mi = 0; mi < 2; ++mi)
#pragma unroll
        for (int ei = 0; ei < 4; ++ei) { u32x2 o; o.x = pk2(outa[mi][ei][0], outa[mi][ei][1]); o.y = pk2(outa[mi][ei][2], outa[mi][ei][3]);
            *(u32x2*)(ys + ((size_t)b * SEQ + trow[mi]) * YLD + 1024 + hh * 64 + ei * 16 + fq * 4) = o; }
    __syncthreads();
}

__device__ __forceinline__ void convmod_item(const Params& p, int l, int item, lptr lds) {
    int tid_ = threadIdx.x; asm volatile("" : "+v"(tid_)); const int tid = tid_, wave = __builtin_amdgcn_readfirstlane(tid >> 6), lane = tid & 63;
    const int b = item >> 6, sp0 = (item & 63) * 32;
    const bf16_t* projb = (const bf16_t*)(p.ws + WS_PROJ) + (size_t)b * SEQ * PLD; bf16_t* ys = (bf16_t*)(p.ws + WS_YS);
    lptr glu = lds; LAS float* yf = (LAS float*)(lds + 63488);
#pragma unroll 4
    for (int idx = tid; idx < 62 * 64; idx += NT) { const int j = idx >> 6, c8 = (idx & 63) * 8; const int sp = sp0 - 30 + j; float o[8];
        if (sp >= 0) { float a[8], bb[8]; unpack8(*(const u32x4*)(projb + (size_t)sp * PLD + C_AB + c8), a); unpack8(*(const u32x4*)(projb + (size_t)sp * PLD + C_AB + 512 + c8), bb);
#pragma unroll
            for (int e = 0; e < 8; ++e) o[e] = a[e] * sigmoidf_(bb[e]); }
        else {
#pragma unroll
            for (int e = 0; e < 8; ++e) o[e] = 0.f; }
        *(LAS u32x4*)(glu + ((size_t)j * 512 + c8) * 2) = pack8(o); }
    __syncthreads();
    { const int cp = tid & 255, half = tid >> 8; const float* cw = p.in[I_CDW] + (size_t)l * 31 * 512 + 2 * cp;
      float w[31][2];
#pragma unroll
      for (int k = 0; k < 31; ++k) { const f32x2 t = *(const f32x2*)(cw + k * 512); w[k][0] = t.x; w[k][1] = t.y; }
      const f32x2 bs = *(const f32x2*)(p.in[I_CDB] + l * 512 + 2 * cp);
      float acc[16][2];
#pragma unroll
      for (int t = 0; t < 16; ++t) { acc[t][0] = bs.x; acc[t][1] = bs.y; }
#pragma unroll
      for (int jj = 0; jj < 46; ++jj) { const unsigned gw = *(const LAS unsigned*)(glu + ((size_t)(half * 16 + jj) * 512 + 2 * cp) * 2); const float g0 = lo16(gw), g1 = hi16(gw);
#pragma unroll
          for (int t = 0; t < 16; ++t) { const int k = jj - t; if (k >= 0 && k <= 30) { acc[t][0] += w[k][0] * g0; acc[t][1] += w[k][1] * g1; } } }
#pragma unroll
      for (int t = 0; t < 16; ++t) *(LAS f32x2*)(yf + (half * 16 + t) * 516 + 2 * cp) = (f32x2){acc[t][0], acc[t][1]}; }
    __syncthreads();
    for (int rr = 0; rr < 4; ++rr) { const int t = wave * 4 + rr; const LAS float* yr = yf + t * 516 + lane * 8; const f32x4 a = *(const LAS f32x4*)yr, bb = *(const LAS f32x4*)(yr + 4);
        float f[8] = {a.x, a.y, a.z, a.w, bb.x, bb.y, bb.z, bb.w}; float ss = 0.f;
#pragma unroll
        for (int e = 0; e < 8; ++e) ss += f[e] * f[e];
        ss = wave_sum(ss); const float rs = rsqrtf(ss * (1.f / 512.f) + EPS); const float* gn = p.in[I_CNORM] + l * 512 + lane * 8;
#pragma unroll
        for (int e = 0; e < 8; ++e) f[e] = siluf_(f[e] * rs * gn[e]);
        *(u32x4*)(ys + ((size_t)b * SEQ + sp0 + t) * YLD + 1536 + lane * 8) = pack8(f); }
    __syncthreads();
}

__global__ void __launch_bounds__(NT, 2) mega(Params p) {
    extern __shared__ __attribute__((aligned(16))) unsigned char lds_raw[];
    lptr lds = (lptr)lds_raw;
    cg::grid_group grid = cg::this_grid();
    int G = gridDim.x, c = blockIdx.x;
    unsigned char* ws = p.ws;
    volatile LAS unsigned* bst = (volatile LAS unsigned*)(lds + LDS_BYTES - 16);
    if (threadIdx.x < 4) bst[threadIdx.x] = 0u;
    __syncthreads();
    const XcdBarrier xbar = xcd_barrier_post((unsigned*)(p.ws + WS_BAR), bst);
    grid.sync();

#define OPQ() asm volatile("" : "+s"(G), "+s"(c), "+s"(l), "+s"(ws))
    bf16_t* xn = (bf16_t*)(ws + WS_XN); bf16_t* proj = (bf16_t*)(ws + WS_PROJ); bf16_t* hid = proj; unsigned char* gates = (unsigned char*)(ws + WS_GATES);
    bf16_t* ysb = (bf16_t*)(ws + WS_YS); float* mf = (float*)(ws + WS_PROJ); bf16_t* merged = (bf16_t*)(ws + WS_MERGED);
    float* x = p.out;
    const LAS float* rstl_c = (const LAS float*)(lds + 131072); LAS float* rstl = (LAS float*)(lds + 131072);
    float* rsqA = (float*)(ws + WS_RSQ); float* rsqB = rsqA + NTOK * 16; float* rsqC = rsqB + NTOK * 16;
    for (int li = 0; li < NLAYER; ++li) {
        int l = li; OPQ();
        const float* xin = l == 0 ? p.in[I_X] : x;
        if (l == 0) { convert_phase(p, 0, lds); norm_phase(xin, p.in[I_F1N], xn, rsqA);
            xcd_barrier(xbar); OPQ(); }
        { pg8::Gemm g{xn, (const bf16_t*)(ws + WS_W1IN), DM, DM}; pg8::StaticOrder S; S.init(NTOK, NFF, G, c); rstd_prologue(S, rsqA, rstl); pg8::EpiSwiglu E{hid, rstl}; pg8::gemm_phase(lds, g, S, E); }
        xcd_barrier(xbar); OPQ();
        { pg8::Gemm g{hid, (const bf16_t*)(ws + WS_W1OUT), FF, FF}; pg8::StaticOrder S; S.init(NTOK, DM, G, c); pg8::EpiResid E{xin, x, 0.5f, xn, p.in[I_MIXN] + l * DM, rsqB}; pg8::gemm_phase(lds, g, S, E); }
        xcd_barrier(xbar); OPQ();
        { pg8::Gemm g{xn, (const bf16_t*)(ws + WS_WIN), DM, DM}; pg8::StaticOrder S; S.init(NTOK, NIN, G, c); rstd_prologue(S, rsqB, rstl); pg8::EpiInproj E{proj, gates, rstl}; pg8::gemm_phase(lds, g, S, E); }
        xcd_barrier(xbar); OPQ();
        {
            if (MIX_MASK & 4) qknorm_pass(proj, p.in[I_QN] + l * 64, p.in[I_KN] + l * 64);
            constexpr int N_CMP = 64, N_SGU = 128, N_MB1 = 256, N_CV = 512, N_TOT = N_CMP + N_SGU + N_MB1 + N_CV;
            unsigned* ctr = (unsigned*)(ws + WS_BAR + 14336) + (l * 2) * 64;
            for (int it = c; it < N_TOT; ) { int r = it;
                unsigned nxt_it = 0u; if (threadIdx.x == 0) nxt_it = G + atomicAdd(ctr, 1u);
                if (r < N_CMP) { if (MIX_MASK & 4) compress_item(p, l, r, lds); }
                else if ((r -= N_CMP) < N_SGU) { if (MIX_MASK & 1) sgu_item(p, l, r, lds); }
                else if ((r -= N_SGU) < N_MB1) { if (MIX_MASK & 2) mamba1_item(p, l, r, lds); }
                else { r -= N_MB1; if (MIX_MASK & 8) convmod_item(p, l, r, lds); }
                if (threadIdx.x == 0) bst[2] = nxt_it;
                __syncthreads(); it = (int)bst[2]; __syncthreads(); }
        }
        xcd_barrier(xbar); OPQ();
        if (MIX_MASK & 2) prefix_phase(p);
        xcd_barrier(xbar); OPQ();
        {
            constexpr int N_MB2 = 128, N_ATT = 512, N_CVB = (CV_NB + 31) / 32, N_CVA = (CV_NA + 31) / 32;
            unsigned* ctr = (unsigned*)(ws + WS_BAR + 14336) + (l * 2 + 1) * 64;
            const int n_tot = N_MB2 + N_ATT + N_CVB + (l < NLAYER - 1 ? N_CVA : 0);
            for (int it = c; it < n_tot; ) { int r = it;
                unsigned nxt_it = 0u; if (threadIdx.x == 0) nxt_it = G + atomicAdd(ctr, 1u);
                if (r < N_MB2) { if (MIX_MASK & 2) mamba2_item(p, l, r, lds); }
                else if ((r -= N_MB2) < N_ATT) { const int qt = 31 - (r >> 4), bg = r & 15; if (MIX_MASK & 4) nsa_item(p, l, (bg << 5) | qt, lds); }
                else convert_wg_item(p, l, r - N_ATT, lds);
                if (threadIdx.x == 0) bst[2] = nxt_it;
                __syncthreads(); it = (int)bst[2]; __syncthreads(); }
        }
        xcd_barrier(xbar); OPQ();
        { pg8::Gemm g{ysb, (const bf16_t*)(ws + WS_WB), YLD, 512}; pg8::MergeOrder S; S.init(G, c); pg8::EpiMerge E{gates, merged}; pg8::gemm_phase(lds, g, S, E); }
        xcd_barrier(xbar); OPQ();
        { pg8::Gemm g{merged, (const bf16_t*)(ws + WS_WO), DM, DM}; pg8::StaticOrder S; S.init(NTOK, DM, G, c); pg8::EpiResid E{x, x, 1.0f, xn, p.in[I_F2N] + l * DM, rsqC}; pg8::gemm_phase(lds, g, S, E); }
        xcd_barrier(xbar); OPQ();
        { pg8::Gemm g{xn, (const bf16_t*)(ws + WS_W2IN), DM, DM}; pg8::StaticOrder S; S.init(NTOK, NFF, G, c); rstd_prologue(S, rsqC, rstl); pg8::EpiSwiglu E{hid, rstl}; pg8::gemm_phase(lds, g, S, E); }
        xcd_barrier(xbar); OPQ();
        { const bool lastl = (l == NLAYER - 1); pg8::Gemm g{hid, (const bf16_t*)(ws + WS_W2OUT), FF, FF}; pg8::StaticOrder S; S.init(NTOK, DM, G, c);
          pg8::EpiResid E{x, x, 0.5f, lastl ? (bf16_t*)nullptr : xn, p.in[I_F1N] + (lastl ? l : l + 1) * DM, rsqA}; pg8::gemm_phase(lds, g, S, E); }
        xcd_barrier(xbar); OPQ();
    }
}

extern "C" void kernel_launch(void* const* d_in, const int* in_sizes, int n_in, void* d_out, int out_size, void* d_ws, size_t ws_size, hipStream_t stream) {
    static int grid_blocks = 0;
    if (grid_blocks == 0) {
        if (n_in != 31 || out_size != NTOK * DM || ws_size < WS_END) { fprintf(stderr, "kernel_launch: unexpected shapes (n_in %d, out %d, ws %zu need %zu)\n", n_in, out_size, ws_size, (size_t)WS_END); grid_blocks = -1; return; }
        int dev = 0, cus = 0, per_cu = 0;
        hipGetDevice(&dev);
        hipDeviceGetAttribute(&cus, hipDeviceAttributeMultiprocessorCount, dev);
        if (hipFuncSetAttribute((const void*)mega, hipFuncAttributeMaxDynamicSharedMemorySize, LDS_BYTES) != hipSuccess) { fprintf(stderr, "kernel_launch: hipFuncSetAttribute failed\n"); grid_blocks = -1; return; }
        if (hipOccupancyMaxActiveBlocksPerMultiprocessor(&per_cu, (const void*)mega, NT, LDS_BYTES) != hipSuccess || per_cu < 1) { fprintf(stderr, "kernel_launch: occupancy query gave %d\n", per_cu); per_cu = 1; }
        (void)hipGetLastError();
        grid_blocks = cus * 1;
        (void)per_cu;
    }
    if (grid_blocks < 0) return;
    Params p{};
    for (int i = 0; i < 31; ++i) p.in[i] = (const float*)d_in[i];
    p.out = (float*)d_out; p.ws = (unsigned char*)d_ws;
    if (hipMemsetAsync((char*)d_ws + WS_BAR, 0, 16384, stream) != hipSuccess) { fprintf(stderr, "kernel_launch: memset failed\n"); return; }
    void* args[] = {&p};
    hipError_t e = hipLaunchCooperativeKernel((const void*)mega, dim3(grid_blocks), dim3(NT), args, LDS_BYTES, stream);
    if (e != hipSuccess) fprintf(stderr, "cooperative launch failed: %s (grid %d)\n", hipGetErrorString(e), grid_blocks);
}
```

```cpp
#include <hip/hip_runtime.h>
#include <hip/hip_cooperative_groups.h>
#include <cstdio>
namespace cg = cooperative_groups;

#define LAS __attribute__((address_space(3)))
typedef unsigned short bf16_t;
typedef short bf16x8 __attribute__((ext_vector_type(8)));
typedef float f32x4 __attribute__((ext_vector_type(4)));
typedef float f32x2 __attribute__((ext_vector_type(2)));
typedef unsigned u32x4 __attribute__((ext_vector_type(4)));
typedef unsigned u32x2 __attribute__((ext_vector_type(2)));
typedef LAS unsigned char* lptr;

#ifndef GEMM_ALIGN
#define GEMM_ALIGN true
#endif
#ifndef GEMM_SP2
#define GEMM_SP2 true
#endif
#ifndef PROBE_REP
#define PROBE_REP 1
#endif
#ifndef MIX_MASK
#define MIX_MASK 15
#endif

constexpr int NTOK = 16384, SEQ = 2048, DM = 1024, FF = 2816, NFF = 5632, PLD = 4896, NIN = 9216, NLAYER = 4;
constexpr int YLD = 2048;
constexpr int NT = 512;
constexpr int LDS_BYTES = 147456;
constexpr float EPS = 1e-6f;
constexpr int C_U = 0, C_V = 512, C_Z = 1024, C_XBC = 1536, C_Q = 2560, C_KC = 3072, C_VC = 3200, C_KS = 3328, C_VS = 3456, C_KW = 3584, C_VW = 3712,
              C_AB = 3840, C_DT = 4864, C_GATE = 4872;

constexpr size_t WS_W1IN = 0;
constexpr size_t WS_W1OUT = WS_W1IN + (size_t)NFF * DM * 2;
constexpr size_t WS_WIN = WS_W1OUT + (size_t)DM * FF * 2;
constexpr size_t WS_WB = WS_WIN + (size_t)NIN * DM * 2;
constexpr size_t WS_WO = WS_WB + (size_t)4096 * 512 * 2;
constexpr size_t WS_W2IN = WS_WO + (size_t)DM * DM * 2;
constexpr size_t WS_W2OUT = WS_W2IN + (size_t)NFF * DM * 2;
constexpr size_t WS_WC1K = WS_W2OUT + (size_t)DM * FF * 2;
constexpr size_t WS_WC1V = WS_WC1K + (size_t)128 * 2048 * 2;
constexpr size_t WS_WC2K = WS_WC1V + (size_t)128 * 2048 * 2;
constexpr size_t WS_WC2V = WS_WC2K + (size_t)64 * 128 * 2;
constexpr size_t WS_WEND = WS_WC2V + (size_t)64 * 128 * 2;
constexpr size_t WS_XN = 64ull << 20;
constexpr size_t WS_PROJ = WS_XN + (size_t)NTOK * DM * 2;
constexpr size_t WS_MERGED = WS_PROJ + (size_t)NTOK * DM * 4;
constexpr size_t WS_GATES = WS_PROJ + (size_t)NTOK * PLD * 2;
constexpr size_t WS_YS = WS_GATES + (size_t)NTOK * 4096 * 2;
constexpr size_t WS_STATES = WS_YS + (size_t)NTOK * YLD * 2;
constexpr size_t WS_ATOT = WS_STATES + (size_t)8 * 16 * 8 * 64 * 128 * 4;
constexpr size_t WS_KCMP = WS_ATOT + 4096;
constexpr size_t WS_VCMPT = WS_KCMP + (size_t)8 * 2 * 128 * 64 * 2;
constexpr size_t WS_SINB = WS_VCMPT + (size_t)8 * 2 * 128 * 64 * 2;
constexpr size_t WS_RSQ = WS_SINB + (size_t)8 * 16 * 8 * 8192 * 2;
constexpr size_t WS_BAR = WS_RSQ + 3 * 16 * 65536;
constexpr size_t WS_END = WS_BAR + 16384;
static_assert(WS_WEND <= WS_XN, "weights region");

struct Params {
    const float* in[31];
    float* out;
    unsigned char* ws;
};
enum { I_X = 0, I_F1N, I_F1WI, I_F1WO, I_MIXN, I_WIN, I_SGUVN, I_SGUW, I_SGUB, I_SCW, I_SCB, I_SDTB, I_SALOG, I_SD, I_SNORM, I_QN, I_KN, I_PEK, I_W1K, I_W2K,
       I_PEV, I_W1V, I_W2V, I_CDW, I_CDB, I_CNORM, I_WBR, I_WOUT, I_F2N, I_F2WI, I_F2WO };

__device__ __forceinline__ float bf2f(bf16_t b) { return __uint_as_float(((unsigned)b) << 16); }
typedef __bf16 bf16x2_t __attribute__((ext_vector_type(2)));
__device__ __forceinline__ unsigned pk2(float lo, float hi) { const f32x2 v = {lo, hi}; const bf16x2_t b = __builtin_convertvector(v, bf16x2_t); return __builtin_bit_cast(unsigned, b); }
__device__ __forceinline__ bf16_t f2bf(float f) { return (bf16_t)(pk2(f, 0.f) & 0xffffu); }
__device__ __forceinline__ float lo16(unsigned w) { return __uint_as_float(w << 16); }
__device__ __forceinline__ float hi16(unsigned w) { return __uint_as_float(w & 0xffff0000u); }
__device__ __forceinline__ void unpack8(u32x4 v, float* f) { f[0] = lo16(v.x); f[1] = hi16(v.x); f[2] = lo16(v.y); f[3] = hi16(v.y); f[4] = lo16(v.z); f[5] = hi16(v.z); f[6] = lo16(v.w); f[7] = hi16(v.w); }
__device__ __forceinline__ u32x4 pack8(const float* f) { u32x4 o; o.x = pk2(f[0], f[1]); o.y = pk2(f[2], f[3]); o.z = pk2(f[4], f[5]); o.w = pk2(f[6], f[7]); return o; }
__device__ __forceinline__ float rcpf(float x) { return __builtin_amdgcn_rcpf(x); }
__device__ __forceinline__ float sigmoidf_(float x) { return rcpf(1.0f + __expf(-x)); }
__device__ __forceinline__ float siluf_(float x) { return x * sigmoidf_(x); }
__device__ __forceinline__ float gelu_tanh(float v) { const float u = 0.7978845608f * (v + 0.044715f * v * v * v); return v * rcpf(1.0f + __expf(-2.0f * u)); }
__device__ __forceinline__ float wave_sum(float v) {
#pragma unroll
    for (int o = 32; o >= 1; o >>= 1) v += __shfl_xor(v, o);
    return v;
}
__device__ __forceinline__ f32x4 MF(bf16x8 a, bf16x8 b, f32x4 c) { return __builtin_amdgcn_mfma_f32_16x16x32_bf16(a, b, c, 0, 0, 0); }
__device__ __forceinline__ bf16x8 ldfrag(lptr base, int off_elems) { return *(const LAS bf16x8*)(base + (size_t)off_elems * 2); }
__device__ __forceinline__ bf16x8 ldfrag2(lptr base, int off0, int off1) {
    const u32x2 a = *(const LAS u32x2*)(base + (size_t)off0 * 2), b = *(const LAS u32x2*)(base + (size_t)off1 * 2);
    u32x4 v; v.x = a.x; v.y = a.y; v.z = b.x; v.w = b.y; return __builtin_bit_cast(bf16x8, v);
}
typedef short s16x4 __attribute__((ext_vector_type(4)));
__device__ __forceinline__ bf16x8 ldfrag_tr(lptr base, int ld, int k0, int k1, int n0, int lane) {
    const int g = lane >> 4, q = (lane & 15) >> 2, pp = lane & 3;
    const LAS s16x4* a0 = (const LAS s16x4*)(base + (size_t)((k0 + 4 * g + q) * ld + n0 + 4 * pp) * 2);
    const LAS s16x4* a1 = (const LAS s16x4*)(base + (size_t)((k1 + 4 * g + q) * ld + n0 + 4 * pp) * 2);
    const s16x4 lo = __builtin_amdgcn_ds_read_tr16_b64_v4i16((LAS s16x4*)a0), hi = __builtin_amdgcn_ds_read_tr16_b64_v4i16((LAS s16x4*)a1);
    bf16x8 r; r[0] = lo[0]; r[1] = lo[1]; r[2] = lo[2]; r[3] = lo[3]; r[4] = hi[0]; r[5] = hi[1]; r[6] = hi[2]; r[7] = hi[3]; return r;
}
__device__ __forceinline__ bf16x8 packfrag(f32x4 t0, f32x4 t1) { u32x4 v; v.x = pk2(t0[0], t0[1]); v.y = pk2(t0[2], t0[3]); v.z = pk2(t1[0], t1[1]); v.w = pk2(t1[2], t1[3]); return __builtin_bit_cast(bf16x8, v); }
__device__ __forceinline__ void lds_st16(lptr p, bf16_t v) { *(LAS bf16_t*)p = v; }


#define XB_TMO      128
#define XB_XCNT(j)  (256  + 64 * (j))
#define XB_XSUB(j)  (1280 + 64 * (j))
#define XB_XGEN(j)  (2304 + 64 * (j))
#define XB_TOP      3328
#define XB_TOPGEN   3392
#define XCD_BAR_WORDS 3456
#define XB_SPIN_CAP (1u << 22)
__device__ __forceinline__ unsigned xb_ld(unsigned* p)              { return __hip_atomic_load(p, __ATOMIC_RELAXED, __HIP_MEMORY_SCOPE_AGENT); }
__device__ __forceinline__ unsigned xb_add(unsigned* p, unsigned v) { return __hip_atomic_fetch_add(p, v, __ATOMIC_RELAXED, __HIP_MEMORY_SCOPE_AGENT); }
__device__ __forceinline__ unsigned xb_xcc_id() { return (unsigned)__builtin_amdgcn_s_getreg((3 << 11) | 20) & 0xFu; }
#define XB_SPIN(cond, bar) do { unsigned _sp = 0; while (cond) { __builtin_amdgcn_s_sleep(1); \
    if ((++_sp & 255u) == 0u) { if (xb_ld(&(bar)[XB_TMO])) break; if (_sp > XB_SPIN_CAP) { atomicAdd(&(bar)[XB_TMO], 1u); break; } } } } while (0)
struct XcdBarrier { unsigned* bar; unsigned x; volatile LAS unsigned* st; };
__device__ __forceinline__ XcdBarrier xcd_barrier_post(unsigned* bar, volatile LAS unsigned* st) {
    XcdBarrier b; b.bar = bar; b.x = xb_xcc_id(); b.st = st;
    if (threadIdx.x == 0) (void)xb_add(&bar[XB_XCNT(b.x)], 1u);
    return b;
}
__device__ __forceinline__ void xcd_barrier_complete(unsigned* bar, unsigned x, unsigned& nloc, unsigned& nx) {
    const unsigned G = gridDim.x * gridDim.y * gridDim.z;
    unsigned sum, cnt, mine, sp = 0u;
    for (;;) {
        sum = 0u; cnt = 0u; mine = 0u;
#pragma unroll
        for (unsigned j = 0; j < 16; ++j) { const unsigned c = xb_ld(&bar[XB_XCNT(j)]); sum += c; cnt += (c > 0u) ? 1u : 0u; mine = (j == x) ? c : mine; }
        if (sum == G) break;
        __builtin_amdgcn_s_sleep(1);
        if ((++sp & 255u) == 0u) { if (xb_ld(&bar[XB_TMO])) break; if (sp > XB_SPIN_CAP) { atomicAdd(&bar[XB_TMO], 1u); break; } }
    }
    nloc = mine > 0u ? mine : 1u; nx = cnt > 0u ? cnt : 1u;
}
__device__ __forceinline__ void xcd_barrier(const XcdBarrier& b) {
    asm volatile("s_waitcnt vmcnt(0)" ::: "memory");
    __syncthreads();
    if (threadIdx.x == 0) {
        unsigned* bar = b.bar;
        __builtin_amdgcn_s_waitcnt(0);
        unsigned nloc = b.st[0], nx = b.st[1];
        if (nloc == 0u) { xcd_barrier_complete(bar, b.x, nloc, nx); b.st[0] = nloc; b.st[1] = nx; }
        const unsigned old = xb_add(&bar[XB_XSUB(b.x)], 1u);
        const unsigned gen = old / nloc;
        if (old + 1u == (gen + 1u) * nloc) {
            __builtin_amdgcn_fence(__ATOMIC_RELEASE, "agent");
            asm volatile("s_waitcnt vmcnt(0)" ::: "memory");
            const unsigned og = xb_add(&bar[XB_TOP], 1u);
            const unsigned tg = og / nx;
            if (og + 1u == (tg + 1u) * nx) xb_add(&bar[XB_TOPGEN], 1u);
            else XB_SPIN(xb_ld(&bar[XB_TOPGEN]) == tg, bar);
            __builtin_amdgcn_fence(__ATOMIC_ACQUIRE, "agent");
            xb_add(&bar[XB_XGEN(b.x)], 1u);
            asm volatile("s_waitcnt vmcnt(0)" ::: "memory");
        } else {
            XB_SPIN(xb_ld(&bar[XB_XGEN(b.x)]) == gen, bar);
            __builtin_amdgcn_fence(__ATOMIC_ACQUIRE, "agent");
            asm volatile("s_waitcnt vmcnt(0)" ::: "memory");
        }
    }
    __syncthreads();
}

namespace pg8 {
constexpr int BM = 256, BK = 64, HALF = 128, HTB = HALF * BK * 2, STAGE_BYTES = 8 * HTB, NXCD = 8, WGM = 8;
__device__ __forceinline__ int lds_byte(int r, int c) { const int st = (r >> 4) * 2 + (c >> 5), rr = r & 15, cc = c & 31, ob = rr * 64 + cc * 2; return st * 1024 + (ob ^ (((ob >> 9) & 1) << 5)); }
__device__ __forceinline__ void stage_rc(int b, int& R, int& C) { const int st = b / 1024, sb = b % 1024, swz = sb ^ (((sb >> 9) & 1) << 5); R = (st >> 1) * 16 + swz / 64; C = (st & 1) * 32 + (swz % 64) / 2; }
__device__ __forceinline__ int perm32(int rho) { const int n = rho >> 4, i = rho & 15; return 8 * (i >> 2) + 4 * n + (i & 3); }

struct Unit { int pm, pn, acol, ord; };
struct Gemm { const bf16_t* A; const bf16_t* Bt; int lda, K; };

struct StaticOrder {
    int nM, nN, nwg, G, c;
    __device__ void init(int M, int N, int G_, int c_) { nM = M / BM; nN = N / BM; nwg = nM * nN; G = G_; c = c_; }
    __device__ bool next(int i, Unit& u) const {
        const long L = (long)i * G + c; if (L >= nwg) return false;
        int wgid = (int)L; { const int q = nwg / NXCD, r = nwg % NXCD, xcd = wgid % NXCD, off = wgid / NXCD; wgid = (xcd < r ? xcd * (q + 1) : r * (q + 1) + (xcd - r) * q) + off; }
        const int nig = WGM * nN, gid = wgid / nig, fm = gid * WGM, gsz = (nM - fm) < WGM ? (nM - fm) : WGM;
        u.pm = fm + ((wgid % nig) % gsz); u.pn = (wgid % nig) / gsz; u.acol = 0; u.ord = i; return true;
    }
};
struct MergeOrder {
    StaticOrder so;
    __device__ void init(int G_, int c_) { so.init(NTOK, DM, G_, c_); }
    __device__ bool next(int i, Unit& u) const { Unit b; if (!so.next(i >> 2, b)) return false; const int sub = i & 3; u.pm = b.pm; u.pn = sub * 4 + b.pn; u.acol = sub * 512; u.ord = i; return true; }
};

template <class Epi, class Sched, bool ALIGN_EPI = GEMM_ALIGN, bool SP2 = GEMM_SP2>
__device__ __forceinline__ void gemm_phase(lptr lds, const Gemm g, const Sched& S, const Epi& E) {
    int tid_ = threadIdx.x; asm volatile("" : "+v"(tid_)); const int tid = tid_, wid = __builtin_amdgcn_readfirstlane(tid >> 6), lane = tid & 63, wr = wid >> 2, wc = wid & 3, fr = lane & 15, fq = lane >> 4;
    const int K = g.K, nt = K / BK, lda = g.lda;
    unsigned voffA[2], voffB[2];
#pragma unroll
    for (int i = 0; i < 2; ++i) { int R, C; stage_rc(tid * 16 + i * 8192, R, C); const int Rb = Epi::PERM ? ((R & ~31) + perm32(R & 31)) : R;
        voffA[i] = (unsigned)(R * lda + C) * 2u; voffB[i] = (unsigned)(Rb * K + C) * 2u; }
    const size_t kstep = (size_t)(BK * 2);
    const size_t hstepA = (size_t)HALF * lda * 2, tstepA = 2 * hstepA;
    const size_t hstepB = (size_t)HALF * K * 2, tstepB = 2 * hstepB;
    const unsigned ldsw = (unsigned)wid * 1024u;
    const int aoff = lds_byte(wr * 64 + fr, fq * 8), boff = lds_byte(wc * 32 + fr, fq * 8);
#define PG8_SA(b, h) (((b) * 2 + (h)) * HTB)
#define PG8_SB(b, h) ((4 + (b) * 2 + (h)) * HTB)
#define PG8_STAGE(bufoff, gbase, voff) do { _Pragma("unroll") for (int _i = 0; _i < 2; ++_i) \
        __builtin_amdgcn_global_load_lds((const unsigned*)((const char*)(gbase) + (voff)[_i]), (LAS unsigned*)(lds + (bufoff) + ldsw + _i * 8192), 16, 0, 0); } while (0)
#define PG8_LDA(dst, b, h) do { _Pragma("unroll") for (int m = 0; m < 4; ++m) _Pragma("unroll") for (int k = 0; k < 2; ++k) dst[m][k] = *(const LAS bf16x8*)(lds + PG8_SA(b, h) + aoff + m * 2048 + k * 1024); } while (0)
#define PG8_LDB(dst, b, h) do { _Pragma("unroll") for (int n = 0; n < 2; ++n) _Pragma("unroll") for (int k = 0; k < 2; ++k) dst[n][k] = *(const LAS bf16x8*)(lds + PG8_SB(b, h) + boff + n * 2048 + k * 1024); } while (0)
#define PG8_MMA(ai, bj, At, Bt) do { __builtin_amdgcn_s_setprio(1); _Pragma("unroll") for (int m = 0; m < 4; ++m) _Pragma("unroll") for (int n = 0; n < 2; ++n) _Pragma("unroll") for (int k = 0; k < 2; ++k) \
        acc[ai][bj][m][n] = __builtin_amdgcn_mfma_f32_16x16x32_bf16(Bt[n][k], At[m][k], acc[ai][bj][m][n], 0, 0, 0); __builtin_amdgcn_s_setprio(0); } while (0)
#define PG8_WAIT_V(n) asm volatile("s_waitcnt vmcnt(" #n ")" ::: "memory")
#define PG8_WAIT_L(n) asm volatile("s_waitcnt lgkmcnt(" #n ")" ::: "memory")
#define PG8_BAR __builtin_amdgcn_s_barrier()
#define PG8_SCHED __builtin_amdgcn_sched_barrier(0)
    Unit cur, nxt; int ui = 0;
    if (!S.next(0, cur)) return;
    f32x4 acc[2][2][4][2];
#pragma unroll
    for (int a = 0; a < 2; ++a)
#pragma unroll
        for (int b = 0; b < 2; ++b)
#pragma unroll
            for (int m = 0; m < 4; ++m)
#pragma unroll
                for (int n = 0; n < 2; ++n) acc[a][b][m][n] = (f32x4){0.f, 0.f, 0.f, 0.f};
    bf16x8 At[4][2], B0[2][2], B1[2][2];
    const char* cA = (const char*)g.A + (size_t)cur.pm * tstepA + (size_t)cur.acol * 2; const char* cB = (const char*)g.Bt + (size_t)cur.pn * tstepB;
    if constexpr (SP2) {
        PG8_STAGE(PG8_SB(0, 0), cB, voffB); PG8_STAGE(PG8_SB(0, 1), cB + hstepB, voffB); PG8_STAGE(PG8_SA(0, 0), cA, voffA); PG8_STAGE(PG8_SA(0, 1), cA + hstepA, voffA);
        if (wr == 1) PG8_BAR;
        PG8_WAIT_V(2); PG8_BAR;
        PG8_STAGE(PG8_SB(1, 0), cB + kstep, voffB); PG8_STAGE(PG8_SA(1, 0), cA + kstep, voffA); PG8_STAGE(PG8_SB(1, 1), cB + hstepB + kstep, voffB);
        PG8_WAIT_V(6); PG8_BAR;
    } else {
    PG8_STAGE(PG8_SB(0, 0), cB, voffB); PG8_STAGE(PG8_SA(0, 0), cA, voffA); PG8_STAGE(PG8_SB(0, 1), cB + hstepB, voffB); PG8_STAGE(PG8_SA(0, 1), cA + hstepA, voffA);
    if (wr == 1) PG8_BAR;
    PG8_WAIT_V(4); PG8_BAR;
    PG8_STAGE(PG8_SB(1, 0), cB + kstep, voffB); PG8_STAGE(PG8_SA(1, 0), cA + kstep, voffA); PG8_STAGE(PG8_SB(1, 1), cB + hstepB + kstep, voffB);
    PG8_WAIT_V(6); PG8_BAR;
    }
    for (;;) {
        const bool has_next = S.next(ui + 1, nxt);
        const char* nA = has_next ? (const char*)g.A + (size_t)nxt.pm * tstepA + (size_t)nxt.acol * 2 : cA; const char* nB = has_next ? (const char*)g.Bt + (size_t)nxt.pn * tstepB : cB;
        for (int t = 0; t < nt; t += 2) {
            const bool last = (t == nt - 2);
            const char* a1 = cA + (size_t)(t + 1) * kstep;
            const char* a2 = last ? nA : cA + (size_t)(t + 2) * kstep; const char* b2 = last ? nB : cB + (size_t)(t + 2) * kstep;
            const char* a3 = a2 + kstep; const char* b3 = b2 + kstep;
            if constexpr (SP2) {
            PG8_LDB(B0, 0, 0); PG8_LDB(B1, 0, 1); PG8_SCHED; PG8_LDA(At, 0, 0); PG8_STAGE(PG8_SA(1, 1), a1 + hstepA, voffA);
            PG8_WAIT_V(8); PG8_WAIT_L(0); PG8_BAR; PG8_MMA(0, 0, At, B0); PG8_MMA(0, 1, At, B1); PG8_BAR; PG8_SCHED;
            PG8_LDA(At, 0, 1); PG8_STAGE(PG8_SB(0, 0), b2, voffB); PG8_STAGE(PG8_SB(0, 1), b2 + hstepB, voffB); PG8_STAGE(PG8_SA(0, 0), a2, voffA);
            PG8_WAIT_V(8); PG8_WAIT_L(0); PG8_BAR; PG8_MMA(1, 0, At, B0); PG8_MMA(1, 1, At, B1); PG8_BAR; PG8_SCHED;
            PG8_LDB(B0, 1, 0); PG8_LDB(B1, 1, 1); PG8_SCHED; PG8_LDA(At, 1, 0); PG8_STAGE(PG8_SA(0, 1), a2 + hstepA, voffA);
            PG8_WAIT_V(8); PG8_WAIT_L(0); PG8_BAR; PG8_MMA(0, 0, At, B0); PG8_MMA(0, 1, At, B1); PG8_BAR; PG8_SCHED;
            PG8_LDA(At, 1, 1); PG8_STAGE(PG8_SB(1, 0), b3, voffB); PG8_STAGE(PG8_SB(1, 1), b3 + hstepB, voffB); PG8_STAGE(PG8_SA(1, 0), a3, voffA);
            PG8_WAIT_V(8); PG8_WAIT_L(0); PG8_BAR; PG8_MMA(1, 0, At, B0); PG8_MMA(1, 1, At, B1); PG8_BAR; PG8_SCHED;
            } else {
            PG8_LDB(B0, 0, 0); PG8_SCHED; PG8_LDA(At, 0, 0); PG8_STAGE(PG8_SA(1, 1), a1 + hstepA, voffA);
            PG8_WAIT_L(8); PG8_BAR; PG8_WAIT_L(0); PG8_MMA(0, 0, At, B0); PG8_BAR; PG8_SCHED;
            PG8_LDB(B1, 0, 1); PG8_STAGE(PG8_SB(0, 0), b2, voffB);
            PG8_BAR; PG8_WAIT_L(0); PG8_MMA(0, 1, At, B1); PG8_BAR;
            PG8_LDA(At, 0, 1); PG8_STAGE(PG8_SA(0, 0), a2, voffA);
            PG8_BAR; PG8_WAIT_L(0); PG8_MMA(1, 0, At, B0); PG8_BAR; PG8_SCHED;
            PG8_STAGE(PG8_SB(0, 1), b2 + hstepB, voffB);
            PG8_WAIT_V(6); PG8_BAR; PG8_MMA(1, 1, At, B1); PG8_BAR;
            PG8_LDB(B0, 1, 0); PG8_SCHED; PG8_LDA(At, 1, 0); PG8_STAGE(PG8_SA(0, 1), a2 + hstepA, voffA);
            PG8_WAIT_L(8); PG8_BAR; PG8_WAIT_L(0); PG8_MMA(0, 0, At, B0); PG8_BAR; PG8_SCHED;
            PG8_LDB(B1, 1, 1); PG8_STAGE(PG8_SB(1, 0), b3, voffB);
            PG8_BAR; PG8_WAIT_L(0); PG8_MMA(0, 1, At, B1); PG8_BAR;
            PG8_LDA(At, 1, 1); PG8_STAGE(PG8_SA(1, 0), a3, voffA);
            PG8_BAR; PG8_WAIT_L(0); PG8_MMA(1, 0, At, B0); PG8_BAR; PG8_SCHED;
            PG8_STAGE(PG8_SB(1, 1), b3 + hstepB, voffB);
            PG8_WAIT_V(6); PG8_BAR; PG8_MMA(1, 1, At, B1); PG8_BAR;
            }
        }
        if constexpr (ALIGN_EPI) { if (wr == 0) PG8_BAR; }
        bool zero_acc = true;
        if constexpr (Epi::CHAIN) zero_acc = E.chain(acc, cur, wr, wc, fr, fq); else E(acc, cur, wr, wc, fr, fq);
        if (!has_next) break;
        if (zero_acc)
#pragma unroll
        for (int a = 0; a < 2; ++a)
#pragma unroll
            for (int b = 0; b < 2; ++b)
#pragma unroll
                for (int m = 0; m < 4; ++m)
#pragma unroll
                    for (int n = 0; n < 2; ++n) acc[a][b][m][n] = (f32x4){0.f, 0.f, 0.f, 0.f};
        cur = nxt; cA = nA; cB = nB; ++ui;
        if constexpr (ALIGN_EPI) { if (wr == 1) PG8_BAR; }
    }
    PG8_WAIT_V(0);
    if constexpr (!ALIGN_EPI) { if (wr == 0) PG8_BAR; }
    PG8_BAR;
#undef PG8_SA
#undef PG8_SB
#undef PG8_STAGE
#undef PG8_LDA
#undef PG8_LDB
#undef PG8_MMA
#undef PG8_WAIT_V
#undef PG8_WAIT_L
#undef PG8_BAR
#undef PG8_SCHED
}

__device__ __forceinline__ float row_rstd(const float* rowsq, size_t row) {
    const f32x4* q = (const f32x4*)(rowsq + row * 16); const f32x4 a = q[0], b = q[1], c = q[2], d = q[3];
    const float s = ((a[0] + a[1]) + (a[2] + a[3])) + ((b[0] + b[1]) + (b[2] + b[3])) + ((c[0] + c[1]) + (c[2] + c[3])) + ((d[0] + d[1]) + (d[2] + d[3]));
    return rsqrtf(s * (1.f / DM) + EPS);
}
struct EpiResid {
    static constexpr bool PERM = false, CHAIN = false;
    const float* xin; float* out; float scale; bf16_t* xq; const float* gnext; float* rowsq;
    __device__ __forceinline__ void operator()(const f32x4 (&acc)[2][2][4][2], const Unit& u, int wr, int wc, int fr, int fq) const {
        const int row0 = u.pm * BM + wr * 64 + fr, col0 = u.pn * BM + wc * 32 + 4 * fq;
        f32x4 gv[2][2];
#pragma unroll
        for (int bj = 0; bj < 2; ++bj)
#pragma unroll
            for (int n = 0; n < 2; ++n) gv[bj][n] = *(const f32x4*)(gnext + col0 + bj * HALF + n * 16);
#pragma unroll
        for (int ai = 0; ai < 2; ++ai)
#pragma unroll
            for (int mp = 0; mp < 2; ++mp) { f32x4 xv[2][2][2];
#pragma unroll
                for (int mm = 0; mm < 2; ++mm)
#pragma unroll
                    for (int bj = 0; bj < 2; ++bj)
#pragma unroll
                        for (int n = 0; n < 2; ++n) xv[mm][bj][n] = *(const f32x4*)(xin + (size_t)(row0 + ai * HALF + (mp * 2 + mm) * 16) * DM + col0 + bj * HALF + n * 16);
#pragma unroll
                for (int mm = 0; mm < 2; ++mm) { const int m = mp * 2 + mm; const int row = row0 + ai * HALF + m * 16; const size_t off = (size_t)row * DM + col0; float ss = 0.f;
#pragma unroll
                    for (int bj = 0; bj < 2; ++bj)
#pragma unroll
                        for (int n = 0; n < 2; ++n) { const f32x4 v = xv[mm][bj][n] + acc[ai][bj][m][n] * scale; *(f32x4*)(out + off + bj * HALF + n * 16) = v;
                            if (xq) { ss += (v[0] * v[0] + v[1] * v[1]) + (v[2] * v[2] + v[3] * v[3]); const f32x4 q = v * gv[bj][n]; u32x2 w; w.x = pk2(q[0], q[1]); w.y = pk2(q[2], q[3]); *(u32x2*)(xq + off + bj * HALF + n * 16) = w; } }
                    if (xq) { ss += __shfl_xor(ss, 16); ss += __shfl_xor(ss, 32); if (fq == 0) rowsq[(size_t)row * 16 + u.pn * 4 + wc] = ss; } } }
    }
};
struct EpiSwiglu {
    static constexpr bool PERM = true, CHAIN = false;
    bf16_t* hid; const LAS float* rst;
    __device__ __forceinline__ void operator()(const f32x4 (&acc)[2][2][4][2], const Unit& u, int wr, int wc, int fr, int fq) const {
        const int row0 = u.pm * BM + wr * 64 + fr, col0 = u.pn * 128 + wc * 32 + 8 * fq;
        float rsv[2][4];
#pragma unroll
        for (int ai = 0; ai < 2; ++ai)
#pragma unroll
            for (int m = 0; m < 4; ++m) rsv[ai][m] = rst[u.ord * 256 + wr * 64 + fr + ai * HALF + m * 16];
#pragma unroll
        for (int ai = 0; ai < 2; ++ai)
#pragma unroll
            for (int m = 0; m < 4; ++m) { float o[8]; const float rs = rsv[ai][m];
#pragma unroll
                for (int n = 0; n < 2; ++n)
#pragma unroll
                    for (int j = 0; j < 4; ++j) o[n * 4 + j] = siluf_(acc[ai][0][m][n][j] * rs) * (acc[ai][1][m][n][j] * rs);
                *(u32x4*)(hid + (size_t)(row0 + ai * HALF + m * 16) * FF + col0) = pack8(o); }
    }
};
struct EpiInproj {
    static constexpr bool PERM = true, CHAIN = false;
    bf16_t* proj; unsigned char* gates; const LAS float* rst;
    __device__ __forceinline__ void operator()(const f32x4 (&acc)[2][2][4][2], const Unit& u, int wr, int wc, int fr, int fq) const {
        const int row0 = u.pm * BM + wr * 64 + fr;
        const int mode = u.pn < 4 ? 0 : (u.pn < 20 ? 1 : 2);
        float rsv[2][4];
#pragma unroll
        for (int ai = 0; ai < 2; ++ai)
#pragma unroll
            for (int m = 0; m < 4; ++m) rsv[ai][m] = rst[u.ord * 256 + wr * 64 + fr + ai * HALF + m * 16];
#pragma unroll
        for (int ai = 0; ai < 2; ++ai)
#pragma unroll
            for (int m = 0; m < 4; ++m) { const size_t row = (size_t)(row0 + ai * HALF + m * 16); const float rs = rsv[ai][m];
#pragma unroll
                for (int bj = 0; bj < 2; ++bj) { float o[8];
                    const int c0 = u.pn * BM + bj * HALF + wc * 32 + 8 * fq;
#pragma unroll
                    for (int n = 0; n < 2; ++n)
#pragma unroll
                        for (int j = 0; j < 4; ++j) { const float v = acc[ai][bj][m][n][j] * rs; o[n * 4 + j] = mode == 0 ? gelu_tanh(v) : (mode == 1 ? v : sigmoidf_(v)); }
                    if (mode == 2) { unsigned w0 = 0u, w1 = 0u;
#pragma unroll
                        for (int j = 0; j < 4; ++j) { w0 = __builtin_amdgcn_cvt_pk_u8_f32(fmaxf(o[j] * 255.f, 1.f), j, w0); w1 = __builtin_amdgcn_cvt_pk_u8_f32(fmaxf(o[4 + j] * 255.f, 1.f), j, w1); }
                        u32x2 wv; wv.x = w0; wv.y = w1; *(u32x2*)(gates + row * 4096 + (c0 - 5120)) = wv; }
                    else if (c0 < PLD) *(u32x4*)(proj + row * PLD + c0) = pack8(o); } }
    }
};
__device__ __forceinline__ void unpack_u8x8(u32x2 w, float* f) {
#pragma unroll
    for (int j = 0; j < 4; ++j) { f[j] = (float)((w.x >> (8 * j)) & 0xffu); f[4 + j] = (float)((w.y >> (8 * j)) & 0xffu); }
}
struct EpiMerge {
    static constexpr bool PERM = true, CHAIN = true;
    const unsigned char* gates; bf16_t* merged;
    __device__ __forceinline__ bool chain(f32x4 (&acc)[2][2][4][2], const Unit& u, int wr, int wc, int fr, int fq) const {
        const int row0 = u.pm * BM + wr * 64 + fr; const int bi = u.pn >> 2, nn = u.pn & 3; const bool lastb = bi == 3;
#pragma unroll
        for (int ai = 0; ai < 2; ++ai)
#pragma unroll
            for (int mp = 0; mp < 2; ++mp) { u32x2 g0[2][2], g1[2][2];
#pragma unroll
                for (int mm = 0; mm < 2; ++mm)
#pragma unroll
                    for (int bj = 0; bj < 2; ++bj) { const size_t row = (size_t)(row0 + ai * HALF + (mp * 2 + mm) * 16); const int c0 = nn * BM + bj * HALF + wc * 32 + 8 * fq;
                        g0[mm][bj] = *(const u32x2*)(gates + row * 4096 + bi * 1024 + c0);
                        g1[mm][bj] = lastb ? g0[mm][bj] : *(const u32x2*)(gates + row * 4096 + (bi + 1) * 1024 + c0); }
#pragma unroll
                for (int mm = 0; mm < 2; ++mm)
#pragma unroll
                    for (int bj = 0; bj < 2; ++bj) { const int m = mp * 2 + mm; const size_t row = (size_t)(row0 + ai * HALF + m * 16); const int c0 = nn * BM + bj * HALF + wc * 32 + 8 * fq; float ga[8], gb[8], o[8];
                        unpack_u8x8(g0[mm][bj], ga); unpack_u8x8(g1[mm][bj], gb);
#pragma unroll
                        for (int n = 0; n < 2; ++n)
#pragma unroll
                            for (int j = 0; j < 4; ++j) { const float f = lastb ? ga[n * 4 + j] * (1.f / 255.f) : ga[n * 4 + j] * rcpf(gb[n * 4 + j]); const float v = acc[ai][bj][m][n][j] * f; acc[ai][bj][m][n][j] = v; o[n * 4 + j] = v; }
                        if (lastb) *(u32x4*)(merged + row * DM + c0) = pack8(o); } }
        return lastb;
    }
};
}


template <class Sched> __device__ __forceinline__ void rstd_prologue(const Sched& S, const float* rowsq, LAS float* rst) {
    int t_ = threadIdx.x; asm volatile("" : "+v"(t_));
    pg8::Unit u;
    for (int i = 0; i < 12 && S.next(i, u); ++i) if (t_ < 256) rst[i * 256 + t_] = pg8::row_rstd(rowsq, (size_t)u.pm * 256 + t_);
    __syncthreads();
}

template <int MODE> __device__ __forceinline__ int srccol(int n) {
    if (MODE == 0) return n;
    if (MODE == 1) { const int tile = n >> 8, w = n & 255; return w < 128 ? tile * 128 + w : FF + tile * 128 + (w - 128); }
    if (n < 2560) return n;
    if (n < 3840) return n + 8;
    if (n < 4864) return n + 32;
    if (n < 4872) return n - 4864 + 2560;
    if (n < 4896) return n - 4872 + 3848;
    if (n < 5120) return -1;
    return n - 224;
}
template <int MODE>
__device__ __forceinline__ void transpose_item(const float* W, int K, int Nsrc, int Ndst, bf16_t* WT, LAS float* scr, int item, int lane) {
    const int nblk = Ndst / 32, kb = item / nblk, nb = item % nblk, k0 = 64 * kb, n0 = 32 * nb;
    const int sc = srccol<MODE>(n0 + (lane & 31));
#pragma unroll
    for (int i = 0; i < 32; ++i) { const int kk = 2 * i + (lane >> 5); scr[kk * 33 + (lane & 31)] = sc >= 0 ? W[(size_t)(k0 + kk) * Nsrc + sc] : 0.f; }
    asm volatile("s_waitcnt lgkmcnt(0)" ::: "memory");
    const int c = lane & 7;
#pragma unroll
    for (int j = 0; j < 4; ++j) { const int n = (lane >> 3) + 8 * j; const LAS float* s = scr + (8 * c) * 33 + n;
        u32x4 o; o.x = pk2(s[0 * 33], s[1 * 33]); o.y = pk2(s[2 * 33], s[3 * 33]); o.z = pk2(s[4 * 33], s[5 * 33]); o.w = pk2(s[6 * 33], s[7 * 33]);
        *(u32x4*)(WT + (size_t)(n0 + n) * K + k0 + 8 * c) = o; }
    asm volatile("s_waitcnt lgkmcnt(0)" ::: "memory");
}
constexpr int CV_I0 = 16 * 176, CV_I1 = 44 * 32, CV_I2 = 16 * 288, CV_I3 = 8 * 32, CV_I7 = 16 * 32, CV_I10 = 32 * 4, CV_I12 = 2 * 2;
constexpr int CV_NA = CV_I0 + CV_I1 + CV_I2 + 2 * CV_I10 + 2 * CV_I12;
constexpr int CV_NB = CV_I0 + CV_I1 + 4 * CV_I3 + CV_I7;
__device__ __forceinline__ void convert_item_A(const Params& p, int l, int r, LAS float* scr, int lane) {
    unsigned char* ws = p.ws;
    if (r < CV_I0) { transpose_item<1>(p.in[I_F1WI] + (size_t)l * DM * NFF, DM, NFF, NFF, (bf16_t*)(ws + WS_W1IN), scr, r, lane); return; } r -= CV_I0;
    if (r < CV_I2) { transpose_item<2>(p.in[I_WIN] + (size_t)l * DM * 8992, DM, 8992, NIN, (bf16_t*)(ws + WS_WIN), scr, r, lane); return; } r -= CV_I2;
    if (r < CV_I1) { transpose_item<0>(p.in[I_F1WO] + (size_t)l * FF * DM, FF, DM, DM, (bf16_t*)(ws + WS_W1OUT), scr, r, lane); return; } r -= CV_I1;
    if (r < CV_I10) { transpose_item<0>(p.in[I_W1K] + (size_t)l * 2048 * 128, 2048, 128, 128, (bf16_t*)(ws + WS_WC1K), scr, r, lane); return; } r -= CV_I10;
    if (r < CV_I10) { transpose_item<0>(p.in[I_W1V] + (size_t)l * 2048 * 128, 2048, 128, 128, (bf16_t*)(ws + WS_WC1V), scr, r, lane); return; } r -= CV_I10;
    if (r < CV_I12) { transpose_item<0>(p.in[I_W2K] + (size_t)l * 128 * 64, 128, 64, 64, (bf16_t*)(ws + WS_WC2K), scr, r, lane); return; } r -= CV_I12;
    transpose_item<0>(p.in[I_W2V] + (size_t)l * 128 * 64, 128, 64, 64, (bf16_t*)(ws + WS_WC2V), scr, r, lane);
}
__device__ __forceinline__ void convert_item_B(const Params& p, int l, int r, LAS float* scr, int lane) {
    unsigned char* ws = p.ws;
    if (r < CV_I0) { transpose_item<1>(p.in[I_F2WI] + (size_t)l * DM * NFF, DM, NFF, NFF, (bf16_t*)(ws + WS_W2IN), scr, r, lane); return; } r -= CV_I0;
    if (r < CV_I1) { transpose_item<0>(p.in[I_F2WO] + (size_t)l * FF * DM, FF, DM, DM, (bf16_t*)(ws + WS_W2OUT), scr, r, lane); return; } r -= CV_I1;
    if (r < 4 * CV_I3) { const int bi = r / CV_I3; transpose_item<0>(p.in[I_WBR] + ((size_t)l * 4 + bi) * 512 * DM, 512, DM, DM, (bf16_t*)(ws + WS_WB) + (size_t)bi * DM * 512, scr, r % CV_I3, lane); return; } r -= 4 * CV_I3;
    transpose_item<0>(p.in[I_WOUT] + (size_t)l * DM * DM, DM, DM, DM, (bf16_t*)(ws + WS_WO), scr, r, lane);
}
__device__ __forceinline__ void convert_phase(const Params& p, int l, lptr lds) {
    int tid_ = threadIdx.x; asm volatile("" : "+v"(tid_)); const int wave = tid_ >> 6, lane = tid_ & 63;
    LAS float* scr = (LAS float*)(lds + wave * 16384);
    const int gw = blockIdx.x * 8 + wave, NGW = gridDim.x * 8;
    for (int it = gw; it < CV_NA; it += NGW) convert_item_A(p, l, it, scr, lane);
}
__device__ __forceinline__ void convert_wg_item(const Params& p, int l, int r2, lptr lds) {
    int tid_ = threadIdx.x; asm volatile("" : "+v"(tid_)); const int wave = tid_ >> 6, lane = tid_ & 63;
    LAS float* scr = (LAS float*)(lds + wave * 16384);
    constexpr int NB_WG = (CV_NB + 31) / 32;
#pragma unroll 1
    for (int k = 0; k < 4; ++k) {
        if (r2 < NB_WG) { const int w = r2 * 32 + k * 8 + wave; if (w < CV_NB) convert_item_B(p, l, w, scr, lane); }
        else { const int w = (r2 - NB_WG) * 32 + k * 8 + wave; if (w < CV_NA) convert_item_A(p, l + 1, w, scr, lane); } }
    __syncthreads();
}
__device__ __forceinline__ void norm_phase(const float* x, const float* g, bf16_t* xn, float* rowsq) {
    int tid_ = threadIdx.x; asm volatile("" : "+v"(tid_)); const int wave = tid_ >> 6, lane = tid_ & 63;
    const int gw = blockIdx.x * 8 + wave, NGW = gridDim.x * 8;
    f32x4 gv[4];
#pragma unroll
    for (int j = 0; j < 4; ++j) gv[j] = *((const f32x4*)g + lane + 64 * j);
    for (int m = gw; m < NTOK; m += NGW) {
        const f32x4* xr = (const f32x4*)(x + (size_t)m * DM) + lane;
        f32x4 v[4]; float s = 0.f;
#pragma unroll
        for (int j = 0; j < 4; ++j) { v[j] = xr[64 * j]; s += (v[j].x * v[j].x + v[j].y * v[j].y) + (v[j].z * v[j].z + v[j].w * v[j].w); }
        s = wave_sum(s); if (lane < 16) rowsq[(size_t)m * 16 + lane] = lane == 0 ? s : 0.f;
        u32x2* o8 = (u32x2*)(xn + (size_t)m * DM) + lane;
#pragma unroll
        for (int j = 0; j < 4; ++j) { u32x2 w; w.x = pk2(v[j].x * gv[j].x, v[j].y * gv[j].y); w.y = pk2(v[j].z * gv[j].z, v[j].w * gv[j].w); o8[64 * j] = w; }
    }
}
__device__ __forceinline__ void zero_rows(float* r) { int t_ = threadIdx.x; asm volatile("" : "+v"(t_)); for (int i = blockIdx.x * NT + t_; i < NTOK; i += gridDim.x * NT) r[i] = 0.f; }

__device__ __forceinline__ void qknorm_pass(bf16_t* proj, const float* qn, const float* kn) {
    int tid_ = threadIdx.x; asm volatile("" : "+v"(tid_));
    for (int idx = blockIdx.x * NT + tid_; idx < NTOK * 12; idx += gridDim.x * NT) {
        const int tok = idx / 12, v = idx % 12;
        const int col = v < 8 ? C_Q + v * 64 : (v < 10 ? C_KS + (v - 8) * 64 : C_KW + (v - 10) * 64);
        const float* w = v < 8 ? qn : kn; const float sc = v < 8 ? 0.125f * 1.4426950408889634f : 1.0f;
        u32x4* ptr = (u32x4*)(proj + (size_t)tok * PLD + col);
        u32x4 raw[8]; float ss = 0.f;
#pragma unroll
        for (int j = 0; j < 8; ++j) { raw[j] = ptr[j]; float f[8]; unpack8(raw[j], f);
#pragma unroll
            for (int e = 0; e < 8; ++e) ss += f[e] * f[e]; }
        const float r = rsqrtf(ss * (1.f / 64.f) + EPS) * sc;
#pragma unroll
        for (int j = 0; j < 8; ++j) { float f[8]; unpack8(raw[j], f);
#pragma unroll
            for (int e = 0; e < 8; ++e) f[e] = f[e] * r * w[j * 8 + e];
            ptr[j] = pack8(f); }
    }
}

__device__ __forceinline__ void sgu_item(const Params& p, int l, int item, lptr lds) {
    int tid_ = threadIdx.x; asm volatile("" : "+v"(tid_)); const int tid = tid_, wave = __builtin_amdgcn_readfirstlane(tid >> 6), lane = tid & 63, fr = lane & 15, fq = lane >> 4;
    const bf16_t* proj = (const bf16_t*)(p.ws + WS_PROJ); bf16_t* ys = (bf16_t*)(p.ws + WS_YS);
    const size_t tok0 = (size_t)item * 128;
    LAS float* rstd = (LAS float*)lds; lptr Ws = lds + 1024, VT = lds + 1024 + 34816;
    const float* vn = p.in[I_SGUVN] + l * 512;
#pragma unroll 8
    for (int rr = 0; rr < 16; ++rr) { const int t = wave * 16 + rr; float f[8]; unpack8(*(const u32x4*)(proj + (tok0 + t) * PLD + C_V + lane * 8), f); float ss = 0.f;
#pragma unroll
        for (int e = 0; e < 8; ++e) ss += f[e] * f[e];
        ss = wave_sum(ss); if (lane == 0) rstd[t] = rsqrtf(ss * (1.f / 512.f) + EPS); }
    __syncthreads();
    for (int g = 0; g < 4; ++g) {
        { const int t = tid >> 2, s0 = (tid & 3) * 32; const float* wrow = p.in[I_SGUW] + (((size_t)l * 4 + g) * 128 + t) * 128 + s0;
#pragma unroll
          for (int j = 0; j < 4; ++j) { const f32x4 a = *(const f32x4*)(wrow + j * 8), b = *(const f32x4*)(wrow + j * 8 + 4); float f[8] = {a.x, a.y, a.z, a.w, b.x, b.y, b.z, b.w};
#pragma unroll
              for (int e = 0; e < 8; ++e) if (s0 + j * 8 + e > t) f[e] = 0.f;
              *(LAS u32x4*)(Ws + ((size_t)t * 136 + s0 + j * 8) * 2) = pack8(f); } }
        { const int s = tid >> 2, d0 = (tid & 3) * 32; const float rs = rstd[s];
#pragma unroll
          for (int j = 0; j < 4; ++j) { float f[8]; unpack8(*(const u32x4*)(proj + (tok0 + s) * PLD + C_V + g * 128 + d0 + j * 8), f);
#pragma unroll
              for (int e = 0; e < 8; ++e) f[e] = f[e] * rs * vn[g * 128 + d0 + j * 8 + e];
              *(LAS u32x4*)(VT + ((size_t)s * 144 + d0 + j * 8) * 2) = pack8(f); } }
        __syncthreads();
        u32x2 upre[8];
#pragma unroll
        for (int ni = 0; ni < 8; ++ni) upre[ni] = *(const u32x2*)(proj + (tok0 + wave * 16 + fr) * PLD + C_U + g * 128 + ni * 16 + fq * 4);
        f32x4 acc[8];
#pragma unroll
        for (int ni = 0; ni < 8; ++ni) acc[ni] = (f32x4){0.f, 0.f, 0.f, 0.f};
        const int nks = (wave >> 1) + 1;
        for (int ks = 0; ks < nks; ++ks) { const bf16x8 a = ldfrag2(Ws, (wave * 16 + fr) * 136 + ks * 32 + fq * 4, (wave * 16 + fr) * 136 + ks * 32 + 16 + fq * 4);
#pragma unroll
            for (int ni = 0; ni < 8; ++ni) { const bf16x8 b = ldfrag_tr(VT, 144, ks * 32, ks * 32 + 16, ni * 16, lane); acc[ni] = MF(b, a, acc[ni]); } }
        const int t = wave * 16 + fr; const float bias = p.in[I_SGUB][((size_t)l * 4 + g) * 128 + t];
#pragma unroll
        for (int ni = 0; ni < 8; ++ni) { const int d = g * 128 + ni * 16 + fq * 4; const u32x2 uu = upre[ni];
            u32x2 o; o.x = pk2(lo16(uu.x) * (acc[ni][0] + bias), hi16(uu.x) * (acc[ni][1] + bias)); o.y = pk2(lo16(uu.y) * (acc[ni][2] + bias), hi16(uu.y) * (acc[ni][3] + bias));
            *(u32x2*)(ys + (tok0 + t) * YLD + d) = o; }
        __syncthreads();
    }
}

__device__ __forceinline__ float dt_acs_wave(const bf16_t* proj, size_t tokbase, int h, float dtb, float A, LAS float* dtv, LAS float* acs, int lane) {
    float d[2], a[2];
#pragma unroll
    for (int i = 0; i < 2; ++i) { const float raw = bf2f(proj[(tokbase + 2 * lane + i) * PLD + C_DT + h]) + dtb;
        const float sp = raw > 0.f ? raw + log1pf(__expf(-raw)) : log1pf(__expf(raw)); d[i] = sp; a[i] = sp * A; }
    float s = a[0] + a[1];
#pragma unroll
    for (int o = 1; o < 64; o <<= 1) { const float t = __shfl_up(s, o); if (lane >= o) s += t; }
    dtv[2 * lane] = d[0]; dtv[2 * lane + 1] = d[1]; acs[2 * lane] = s - a[1]; acs[2 * lane + 1] = s;
    return s;
}
struct Conv8 { float w[4][8]; float bias[8]; };
__device__ __forceinline__ void conv8_load(Conv8& c, const float* cw, const float* cb, int ch0) {
#pragma unroll
    for (int k = 0; k < 4; ++k) { const f32x4 a = *(const f32x4*)(cw + k * 1024 + ch0), b = *(const f32x4*)(cw + k * 1024 + ch0 + 4);
        c.w[k][0] = a.x; c.w[k][1] = a.y; c.w[k][2] = a.z; c.w[k][3] = a.w; c.w[k][4] = b.x; c.w[k][5] = b.y; c.w[k][6] = b.z; c.w[k][7] = b.w; }
    const f32x4 a = *(const f32x4*)(cb + ch0), b = *(const f32x4*)(cb + ch0 + 4);
    c.bias[0] = a.x; c.bias[1] = a.y; c.bias[2] = a.z; c.bias[3] = a.w; c.bias[4] = b.x; c.bias[5] = b.y; c.bias[6] = b.z; c.bias[7] = b.w;
}
__device__ __forceinline__ void ldrow8(const bf16_t* projb, int sp, int col, float* f) {
    if (sp < 0) {
#pragma unroll
        for (int e = 0; e < 8; ++e) f[e] = 0.f;
    } else unpack8(*(const u32x4*)(projb + (size_t)sp * PLD + col), f);
}
#define CONV_STEP(cv, x, y) do { _Pragma("unroll") for (int e_ = 0; e_ < 8; ++e_) { \
        const float v_ = cv.bias[e_] + cv.w[0][e_] * x[0][e_] + cv.w[1][e_] * x[1][e_] + cv.w[2][e_] * x[2][e_] + cv.w[3][e_] * x[3][e_]; y[e_] = siluf_(v_); \
        x[0][e_] = x[1][e_]; x[1][e_] = x[2][e_]; x[2][e_] = x[3][e_]; } } while (0)


template <int NTK, class F>
__device__ __forceinline__ void conv_run(const Conv8& cv, const bf16_t* projb, int sp0, int col, F&& f) {
    u32x4 raw[NTK + 3];
#pragma unroll
    for (int i = 0; i < NTK + 3; ++i) { const int sp = sp0 - 3 + i; raw[i] = sp >= 0 ? *(const u32x4*)(projb + (size_t)sp * PLD + col) : (u32x4){0u, 0u, 0u, 0u}; }
    float x[4][8];
    unpack8(raw[0], x[0]); unpack8(raw[1], x[1]); unpack8(raw[2], x[2]);
#pragma unroll
    for (int i = 0; i < NTK; ++i) { unpack8(raw[i + 3], x[3]); float y[8]; CONV_STEP(cv, x, y); f(i, y); }
}

__device__ __forceinline__ void mamba1_item(const Params& p, int l, int item, lptr lds) {
    int tid_ = threadIdx.x; asm volatile("" : "+v"(tid_)); const int tid = tid_, wave = __builtin_amdgcn_readfirstlane(tid >> 6), lane = tid & 63, fr = lane & 15, fq = lane >> 4;
    const int g = item & 1, c = (item >> 1) & 15, b = item >> 5;
    if (c == 15) return;
    const bf16_t* proj = (const bf16_t*)(p.ws + WS_PROJ); const bf16_t* projb = proj + (size_t)b * SEQ * PLD;
    LAS float* dtv = (LAS float*)lds; LAS float* acs = (LAS float*)(lds + 2048); lptr BT = lds + 4096, XdT = lds + 4096 + 36864;
    float* states = (float*)(p.ws + WS_STATES); float* atot = (float*)(p.ws + WS_ATOT);
    if (wave < 4) { const int h = g * 4 + wave; const float A = -__expf(p.in[I_SALOG][l * 8 + h]);
        const float tot = dt_acs_wave(proj, (size_t)b * SEQ + c * 128, h, p.in[I_SDTB][l * 8 + h], A, dtv + wave * 128, acs + wave * 128, lane);
        if (lane == 63) atot[(b * 16 + c) * 8 + h] = tot; }
    __syncthreads();
    if (tid < 384) { const int cgp = tid % 48, seg = tid / 48; const bool isB = cgp < 16; const int j = isB ? 0 : cgp - 16;
        const int ch0 = isB ? 512 + g * 128 + cgp * 8 : g * 256 + j * 8; const int hl = j >> 3, p0 = (j & 7) * 8;
        Conv8 cv; conv8_load(cv, p.in[I_SCW] + (size_t)l * 4096, p.in[I_SCB] + (size_t)l * 1024, ch0);
        const float aend = acs[hl * 128 + 127];
#pragma unroll 1
        for (int hf = 0; hf < 2; ++hf) { const int tb = seg * 16 + hf * 8;
            conv_run<8>(cv, projb, c * 128 + tb, C_XBC + ch0, [&](int i, const float* y) { const int tl = tb + i;
                const float sc = isB ? 1.f : dtv[hl * 128 + tl] * __expf(aend - acs[hl * 128 + tl]); float ys_[8];
#pragma unroll
                for (int e = 0; e < 8; ++e) ys_[e] = y[e] * sc;
                lptr dst = isB ? BT + ((size_t)tl * 144 + cgp * 8) * 2 : XdT + ((size_t)tl * 272 + hl * 64 + p0) * 2; *(LAS u32x4*)dst = pack8(ys_); }); }
    }
    __syncthreads();
    { const int hl = wave >> 1, pib = (wave & 1) * 2; f32x4 acc[2][8];
#pragma unroll
      for (int i = 0; i < 2; ++i)
#pragma unroll
          for (int ni = 0; ni < 8; ++ni) acc[i][ni] = (f32x4){0.f, 0.f, 0.f, 0.f};
#pragma unroll
      for (int ks = 0; ks < 4; ++ks) { bf16x8 a[2];
#pragma unroll
          for (int i = 0; i < 2; ++i) a[i] = ldfrag_tr(XdT, 272, ks * 32, ks * 32 + 16, hl * 64 + (pib + i) * 16, lane);
#pragma unroll
          for (int ni = 0; ni < 8; ++ni) { const bf16x8 bb = ldfrag_tr(BT, 144, ks * 32, ks * 32 + 16, ni * 16, lane);
#pragma unroll
              for (int i = 0; i < 2; ++i) acc[i][ni] = MF(bb, a[i], acc[i][ni]); } }
      float* st = states + (size_t)((b * 16 + c) * 8 + g * 4 + hl) * 8192;
#pragma unroll
      for (int i = 0; i < 2; ++i)
#pragma unroll
          for (int ni = 0; ni < 8; ++ni) *(f32x4*)(st + ((pib + i) * 16 + fr) * 128 + ni * 16 + fq * 4) = acc[i][ni];
    }
    __syncthreads();
}


__device__ __forceinline__ void prefix_phase(const Params& p) {
    int tid_ = threadIdx.x; asm volatile("" : "+v"(tid_));
    const float* states = (const float*)(p.ws + WS_STATES); const float* atot = (const float*)(p.ws + WS_ATOT); bf16_t* sinb = (bf16_t*)(p.ws + WS_SINB);
    for (int idx = blockIdx.x * NT + tid_; idx < 64 * 2048; idx += gridDim.x * NT) {
        const int bh = idx >> 11, e4 = (idx & 2047) * 4, b = bh >> 3, h = bh & 7;
        f32x4 st[15]; float dec[15];
#pragma unroll
        for (int c = 0; c < 15; ++c) { st[c] = *(const f32x4*)(states + (size_t)((b * 16 + c) * 8 + h) * 8192 + e4); dec[c] = atot[(b * 16 + c) * 8 + h]; }
        f32x4 S = (f32x4){0.f, 0.f, 0.f, 0.f};
#pragma unroll
        for (int c = 0; c < 15; ++c) { S = S * __expf(dec[c]) + st[c]; u32x2 o; o.x = pk2(S[0], S[1]); o.y = pk2(S[2], S[3]);
            *(u32x2*)(sinb + (size_t)((b * 16 + c + 1) * 8 + h) * 8192 + e4) = o; }
    }
}

__device__ __forceinline__ void mamba2_item(const Params& p, int l, int item, lptr lds) {
    int tid_ = threadIdx.x; asm volatile("" : "+v"(tid_)); const int tid = tid_, wave = __builtin_amdgcn_readfirstlane(tid >> 6), lane = tid & 63, fr = lane & 15, fq = lane >> 4;
    const int c = item & 15, b = item >> 4;
    const bf16_t* proj = (const bf16_t*)(p.ws + WS_PROJ); const bf16_t* projb = proj + (size_t)b * SEQ * PLD; bf16_t* ys = (bf16_t*)(p.ws + WS_YS);
    const bf16_t* sinb = (const bf16_t*)(p.ws + WS_SINB);
    LAS float* dtv = (LAS float*)lds; LAS float* acs = (LAS float*)(lds + 4096);
    lptr Cs = lds + 8192, Bs = lds + 43008, XT = lds + 77824, Sin = lds + 96256, XN = lds + 113664;
    const size_t tokbase = (size_t)b * SEQ + c * 128;
    { const int h = wave; const float A = -__expf(p.in[I_SALOG][l * 8 + h]); dt_acs_wave(proj, tokbase, h, p.in[I_SDTB][l * 8 + h], A, dtv + h * 128, acs + h * 128, lane); }
    __syncthreads();
    const int l_row = wave * 16 + fr;
    float ssq = 0.f;
#pragma unroll 1
    for (int g = 0; g < 2; ++g) {
        { const int cgp = tid & 31, seg = tid >> 5; const int ch0 = cgp < 16 ? 512 + g * 128 + cgp * 8 : 768 + g * 128 + (cgp - 16) * 8;
          lptr dst = cgp < 16 ? Bs : Cs; const int n0 = (cgp & 15) * 8;
          Conv8 cv; conv8_load(cv, p.in[I_SCW] + (size_t)l * 4096, p.in[I_SCB] + (size_t)l * 1024, ch0);
          conv_run<8>(cv, projb, c * 128 + seg * 8, C_XBC + ch0, [&](int i, const float* y) { *(LAS u32x4*)(dst + ((size_t)(seg * 8 + i) * 136 + n0) * 2) = pack8(y); }); }
        __syncthreads();
#pragma unroll 1
        for (int hl = 0; hl < 4; ++hl) { const int h = g * 4 + hl;
            u32x2 zpre[4];
#pragma unroll
            for (int pi = 0; pi < 4; ++pi) zpre[pi] = *(const u32x2*)(proj + (tokbase + l_row) * PLD + C_Z + h * 64 + pi * 16 + fq * 4);
            if (tid < 256) { const int cgp = tid & 7, seg = tid >> 3; const int ch0 = h * 64 + cgp * 8;
                Conv8 cv; conv8_load(cv, p.in[I_SCW] + (size_t)l * 4096, p.in[I_SCB] + (size_t)l * 1024, ch0);
                conv_run<4>(cv, projb, c * 128 + seg * 4, C_XBC + ch0, [&](int i, const float* y) { const int tl = seg * 4 + i;
                    *(LAS u32x4*)(XN + ((size_t)tl * 72 + cgp * 8) * 2) = pack8(y); const float d = dtv[h * 128 + tl]; float yd[8];
#pragma unroll
                    for (int e = 0; e < 8; ++e) yd[e] = y[e] * d;
                    *(LAS u32x4*)(XT + ((size_t)tl * 72 + cgp * 8) * 2) = pack8(yd); }); }
            if (c > 0) { const bf16_t* sb = sinb + (size_t)((b * 16 + c) * 8 + h) * 8192;
#pragma unroll
                for (int k = 0; k < 2; ++k) { const int idx = tid * 8 + k * 4096, pp = idx >> 7, n = idx & 127; *(LAS u32x4*)(Sin + ((size_t)pp * 136 + n) * 2) = *(const u32x4*)(sb + idx); } }
            __syncthreads();
            f32x4 y[4];
#pragma unroll
            for (int pi = 0; pi < 4; ++pi) y[pi] = (f32x4){0.f, 0.f, 0.f, 0.f};
            const float al = acs[h * 128 + l_row];
            bf16x8 aC[4];
#pragma unroll
            for (int ks = 0; ks < 4; ++ks) aC[ks] = ldfrag(Cs, (wave * 16 + fr) * 136 + ks * 32 + fq * 8);
            if (c > 0) {
#pragma unroll
                for (int ks = 0; ks < 4; ++ks) {
#pragma unroll
                    for (int pi = 0; pi < 4; ++pi) { const bf16x8 bb = ldfrag(Sin, (pi * 16 + fr) * 136 + ks * 32 + fq * 8); y[pi] = MF(bb, aC[ks], y[pi]); } }
                const float ea = __expf(al);
#pragma unroll
                for (int pi = 0; pi < 4; ++pi) y[pi] *= ea; }
#pragma unroll 1
            for (int ks2 = 0; 2 * ks2 <= wave; ++ks2) {
                f32x4 cb0 = (f32x4){0.f, 0.f, 0.f, 0.f}, cb1 = (f32x4){0.f, 0.f, 0.f, 0.f};
#pragma unroll
                for (int ks = 0; ks < 4; ++ks) { const bf16x8 b0 = ldfrag(Bs, ((2 * ks2) * 16 + fr) * 136 + ks * 32 + fq * 8), b1 = ldfrag(Bs, ((2 * ks2 + 1) * 16 + fr) * 136 + ks * 32 + fq * 8);
                    cb0 = MF(b0, aC[ks], cb0); cb1 = MF(b1, aC[ks], cb1); }
                const f32x4 a0 = *(const LAS f32x4*)(acs + h * 128 + (2 * ks2) * 16 + fq * 4), a1 = *(const LAS f32x4*)(acs + h * 128 + (2 * ks2 + 1) * 16 + fq * 4);
                f32x4 t0, t1;
#pragma unroll
                for (int j = 0; j < 4; ++j) { const int s0 = (2 * ks2) * 16 + fq * 4 + j, s1 = s0 + 16;
                    t0[j] = s0 <= l_row ? cb0[j] * __expf(fminf(al - a0[j], 0.f)) : 0.f;
                    t1[j] = s1 <= l_row ? cb1[j] * __expf(fminf(al - a1[j], 0.f)) : 0.f; }
                const bf16x8 pa = packfrag(t0, t1);
#pragma unroll
                for (int pi = 0; pi < 4; ++pi) { const bf16x8 bb = ldfrag_tr(XT, 72, (2 * ks2) * 16, (2 * ks2 + 1) * 16, pi * 16, lane); y[pi] = MF(bb, pa, y[pi]); } }
            const float Dh = p.in[I_SD][l * 8 + h];
#pragma unroll
            for (int pi = 0; pi < 4; ++pi) { const int pc = pi * 16 + fq * 4; const u32x2 xr = *(const LAS u32x2*)(XN + ((size_t)l_row * 72 + pc) * 2);
                const u32x2 zr = zpre[pi];
                const float xs4[4] = {lo16(xr.x), hi16(xr.x), lo16(xr.y), hi16(xr.y)}, z4[4] = {lo16(zr.x), hi16(zr.x), lo16(zr.y), hi16(zr.y)}; float o[4];
#pragma unroll
                for (int j = 0; j < 4; ++j) { o[j] = (y[pi][j] + xs4[j] * Dh) * siluf_(z4[j]); ssq += o[j] * o[j]; }
                u32x2 ov; ov.x = pk2(o[0], o[1]); ov.y = pk2(o[2], o[3]);
                *(u32x2*)(ys + (tokbase + l_row) * YLD + 512 + h * 64 + pc) = ov; }
            __syncthreads();
        }
    }
    ssq += __shfl_xor(ssq, 16); ssq += __shfl_xor(ssq, 32);
    const float rs = rsqrtf(ssq * (1.f / 512.f) + EPS);
    const float* ng = p.in[I_SNORM] + l * 512;
#pragma unroll 1
    for (int h = 0; h < 8; ++h)
#pragma unroll
        for (int pi = 0; pi < 4; ++pi) { const int col = h * 64 + pi * 16 + fq * 4; u32x2* ptr = (u32x2*)(ys + (tokbase + l_row) * YLD + 512 + col); const u32x2 r = *ptr; const f32x4 gg = *(const f32x4*)(ng + col);
            u32x2 ov; ov.x = pk2(lo16(r.x) * rs * gg.x, hi16(r.x) * rs * gg.y); ov.y = pk2(lo16(r.y) * rs * gg.z, hi16(r.y) * rs * gg.w); *ptr = ov; }
    __syncthreads();
}

__device__ __forceinline__ void compress_item(const Params& p, int l, int item, lptr lds) {
    int tid_ = threadIdx.x; asm volatile("" : "+v"(tid_)); const int tid = tid_, wave = __builtin_amdgcn_readfirstlane(tid >> 6), lane = tid & 63, fr = lane & 15, fq = lane >> 4;
    const int kv = item & 1, half = (item >> 1) & 1, g = (item >> 2) & 1, b = item >> 3;
    const bf16_t* projb = (const bf16_t*)(p.ws + WS_PROJ) + (size_t)b * SEQ * PLD;
    const int col = (kv ? C_VC : C_KC) + g * 64;
    const float* pe = p.in[kv ? I_PEV : I_PEK] + (size_t)l * 2048;
    const bf16_t* w1t = (const bf16_t*)(p.ws + (kv ? WS_WC1V : WS_WC1K)); const bf16_t* w2t = (const bf16_t*)(p.ws + (kv ? WS_WC2V : WS_WC2K));
    bf16_t* kcmp = (bf16_t*)(p.ws + WS_KCMP); bf16_t* vcmpT = (bf16_t*)(p.ws + WS_VCMPT);
    lptr As = lds, Bs = lds + 33792, H1 = lds + 101376, W2s = lds + 118784; LAS float* Of = (LAS float*)lds;
    const int mi = wave >> 1, nib = (wave & 1) * 4;
    f32x4 acc[4];
#pragma unroll
    for (int i = 0; i < 4; ++i) acc[i] = (f32x4){0.f, 0.f, 0.f, 0.f};
    for (int step = 0; step < 8; ++step) {
        { const int r = tid >> 3, q = tid & 7, pp = q >> 1, e0 = (q & 1) * 32; const int cmp = half * 64 + r, pos = 16 * cmp + step * 4 + pp;
#pragma unroll
          for (int j = 0; j < 4; ++j) { float f[8];
              if (pos < SEQ) unpack8(*(const u32x4*)(projb + (size_t)pos * PLD + col + e0 + j * 8), f); else {
#pragma unroll
                  for (int e = 0; e < 8; ++e) f[e] = 0.f; }
              const float* pr = pe + (step * 4 + pp) * 64 + e0 + j * 8;
#pragma unroll
              for (int e = 0; e < 8; ++e) f[e] += pr[e];
              *(LAS u32x4*)(As + ((size_t)r * 264 + pp * 64 + e0 + j * 8) * 2) = pack8(f); } }
        { const int jrow = tid >> 2, k0 = (tid & 3) * 64;
#pragma unroll
          for (int j = 0; j < 8; ++j) *(LAS u32x4*)(Bs + ((size_t)jrow * 264 + k0 + j * 8) * 2) = *(const u32x4*)(w1t + (size_t)jrow * 2048 + step * 256 + k0 + j * 8); }
        __syncthreads();
#pragma unroll
        for (int ks = 0; ks < 8; ++ks) { const bf16x8 a = ldfrag(As, (mi * 16 + fr) * 264 + ks * 32 + fq * 8);
#pragma unroll
            for (int i = 0; i < 4; ++i) { const bf16x8 bb = ldfrag(Bs, ((nib + i) * 16 + fr) * 264 + ks * 32 + fq * 8); acc[i] = MF(bb, a, acc[i]); } }
        __syncthreads();
    }
#pragma unroll
    for (int i = 0; i < 4; ++i) { const int r = mi * 16 + fr, j0 = (nib + i) * 16 + fq * 4; u32x2 o; o.x = pk2(gelu_tanh(acc[i][0]), gelu_tanh(acc[i][1])); o.y = pk2(gelu_tanh(acc[i][2]), gelu_tanh(acc[i][3]));
        *(LAS u32x2*)(H1 + ((size_t)r * 136 + j0) * 2) = o; }
    { const int e = tid >> 3, k0 = (tid & 7) * 16;
#pragma unroll
      for (int j = 0; j < 2; ++j) *(LAS u32x4*)(W2s + ((size_t)e * 136 + k0 + j * 8) * 2) = *(const u32x4*)(w2t + e * 128 + k0 + j * 8); }
    __syncthreads();
    { const int eib = (wave & 1) * 2; f32x4 a2[2] = {(f32x4){0.f, 0.f, 0.f, 0.f}, (f32x4){0.f, 0.f, 0.f, 0.f}};
#pragma unroll
      for (int ks = 0; ks < 4; ++ks) { const bf16x8 a = ldfrag(H1, (mi * 16 + fr) * 136 + ks * 32 + fq * 8);
#pragma unroll
          for (int i = 0; i < 2; ++i) { const bf16x8 bb = ldfrag(W2s, ((eib + i) * 16 + fr) * 136 + ks * 32 + fq * 8); a2[i] = MF(bb, a, a2[i]); } }
#pragma unroll
      for (int i = 0; i < 2; ++i)
#pragma unroll
          for (int j = 0; j < 4; ++j) Of[(mi * 16 + fr) * 65 + (eib + i) * 16 + fq * 4 + j] = a2[i][j]; }
    __syncthreads();
    { const int r = tid >> 3, e0 = (tid & 7) * 8; const int cmp = half * 64 + r; float f[8]; float ss = 0.f;
#pragma unroll
      for (int e = 0; e < 8; ++e) { f[e] = Of[r * 65 + e0 + e]; ss += f[e] * f[e]; }
      ss += __shfl_xor(ss, 1); ss += __shfl_xor(ss, 2); ss += __shfl_xor(ss, 4);
      if (kv == 0) { const float rs = rsqrtf(ss * (1.f / 64.f) + EPS); const float* kn = p.in[I_KN] + l * 64;
#pragma unroll
          for (int e = 0; e < 8; ++e) f[e] = cmp == 127 ? 0.f : f[e] * rs * kn[e0 + e];
          *(u32x4*)(kcmp + ((size_t)(b * 2 + g) * 128 + cmp) * 64 + e0) = pack8(f); }
      else {
#pragma unroll
          for (int e = 0; e < 8; ++e) vcmpT[((size_t)(b * 2 + g) * 64 + e0 + e) * 128 + cmp] = cmp == 127 ? (bf16_t)0 : f2bf(f[e]); } }
    __syncthreads();
}

template <int KIND>
__device__ __forceinline__ void attn_tile(lptr Ks, lptr VT, lptr Qs, int qrow, const int (&trow)[2], float slope, int j, bool masked, const LAS unsigned* selq,
                                          float (&m)[2], float (&lsum)[2], f32x4 (&O)[2][4], int fr, int fq) {
    f32x4 S[2][4];
    unsigned selrow[2] = {0u, 0u};
    if (KIND == 1) { selrow[0] = selq[fr]; selrow[1] = selq[16 + fr]; }
    { f32x4 cb0;
#pragma unroll
      for (int jj = 0; jj < 4; ++jj) cb0[jj] = slope * (float)(fq * 4 + jj);
#pragma unroll
      for (int mi = 0; mi < 2; ++mi) { const float rowneg = (KIND == 1 && ((selrow[mi] >> j) & 1u) == 0u) ? -1e30f : 0.f;
#pragma unroll
          for (int ni = 0; ni < 4; ++ni) S[mi][ni] = cb0 + (slope * (float)(64 * j + 16 * ni) + rowneg); } }
#pragma unroll
    for (int ks = 0; ks < 2; ++ks)
    { const bf16x8 q0 = ldfrag(Qs, (qrow + fr) * 72 + ks * 32 + fq * 8), q1 = ldfrag(Qs, (qrow + 16 + fr) * 72 + ks * 32 + fq * 8);
#pragma unroll
        for (int ni = 0; ni < 4; ++ni) { const bf16x8 kf = ldfrag(Ks, (ni * 16 + fr) * 72 + ks * 32 + fq * 8); S[0][ni] = MF(kf, q0, S[0][ni]); S[1][ni] = MF(kf, q1, S[1][ni]); } }
    if (masked) {
#pragma unroll
        for (int mi = 0; mi < 2; ++mi) { const int tl = trow[mi] - 64 * j - fq * 4;
#pragma unroll
            for (int ni = 0; ni < 4; ++ni)
#pragma unroll
                for (int jj = 0; jj < 4; ++jj) { const bool valid = KIND == 1 ? (ni * 16 + jj <= tl) : ((unsigned)(tl - (ni * 16 + jj)) < 256u); S[mi][ni][jj] = valid ? S[mi][ni][jj] : -1e30f; } }
    }
#pragma unroll
    for (int mi = 0; mi < 2; ++mi) { float mx = -1e30f;
#pragma unroll
        for (int ni = 0; ni < 4; ++ni)
#pragma unroll
            for (int jj = 0; jj < 4; ++jj) mx = fmaxf(mx, S[mi][ni][jj]);
        mx = fmaxf(mx, __shfl_xor(mx, 16)); mx = fmaxf(mx, __shfl_xor(mx, 32));
        const float mnew = fmaxf(m[mi], mx); const float alpha = __builtin_amdgcn_exp2f(m[mi] - mnew); const float msub = fmaxf(mnew, -1e29f); float sum = 0.f;
#pragma unroll
        for (int ni = 0; ni < 4; ++ni)
#pragma unroll
            for (int jj = 0; jj < 4; ++jj) { const float pv = __builtin_amdgcn_exp2f(S[mi][ni][jj] - msub); S[mi][ni][jj] = pv; sum += pv; }
        sum += __shfl_xor(sum, 16); sum += __shfl_xor(sum, 32);
        lsum[mi] = lsum[mi] * alpha + sum; m[mi] = mnew;
#pragma unroll
        for (int ei = 0; ei < 4; ++ei) O[mi][ei] *= alpha; }
#pragma unroll
    for (int ks2 = 0; ks2 < 2; ++ks2)
#pragma unroll
        for (int ei = 0; ei < 4; ++ei) { const bf16x8 vf = ldfrag_tr(VT, 72, (2 * ks2) * 16, (2 * ks2 + 1) * 16, ei * 16, fq * 16 + fr);
#pragma unroll
            for (int mi = 0; mi < 2; ++mi) O[mi][ei] = MF(vf, packfrag(S[mi][2 * ks2], S[mi][2 * ks2 + 1]), O[mi][ei]); }
}
__device__ __forceinline__ void kv_load(u32x4& kr, u32x4& vr, const bf16_t* projb, int j, int kcol, int vcol, int tid) {
    const int row = tid >> 3, ch = tid & 7; const bf16_t* src = projb + (size_t)(64 * j + row) * PLD;
    kr = *(const u32x4*)(src + kcol + ch * 8); vr = *(const u32x4*)(src + vcol + ch * 8);
}
__device__ __forceinline__ void kv_store(lptr Ks, lptr VT, const u32x4 kr, const u32x4 vr, int tid) {
    const int row = tid >> 3, ch = tid & 7;
    *(LAS u32x4*)(Ks + ((size_t)row * 72 + ch * 8) * 2) = kr;
    *(LAS u32x4*)(VT + ((size_t)row * 72 + ch * 8) * 2) = vr;
}
__device__ __forceinline__ void nsa_item(const Params& p, int l, int item, lptr lds) {
    int tid_ = threadIdx.x; asm volatile("" : "+v"(tid_)); const int tid = tid_, wave = __builtin_amdgcn_readfirstlane(tid >> 6), lane = tid & 63, fr = lane & 15, fq = lane >> 4;
    const int qt = item & 31, g = (item >> 5) & 1, b = item >> 6; const int t0 = qt * 64, cur = qt;
    const bf16_t* projb = (const bf16_t*)(p.ws + WS_PROJ) + (size_t)b * SEQ * PLD; bf16_t* ys = (bf16_t*)(p.ws + WS_YS);
    const bf16_t* kcmp = (const bf16_t*)(p.ws + WS_KCMP) + (size_t)(b * 2 + g) * 8192; const bf16_t* vcmpT = (const bf16_t*)(p.ws + WS_VCMPT) + (size_t)(b * 2 + g) * 8192;
    lptr Ks = lds, VT = lds + 9216, Ks1 = lds + 125184, VT1 = lds + 134400; LAS float* Pc = (LAS float*)(lds + 18432); LAS unsigned* selm = (LAS unsigned*)(lds + 52224); lptr Kc = lds + 52480, VcT = lds + 70912;
    const int r = wave >> 1, qh = wave & 1, hh = g * 4 + r; const float slope = exp2f(-(float)(hh + 1)) * 1.4426950408889634f;
    int trow[2]; lptr Qs = lds + 88320; const int qrow = wave * 32;
#pragma unroll
    for (int mi = 0; mi < 2; ++mi) { trow[mi] = t0 + qh * 32 + mi * 16 + fr;
#pragma unroll
        for (int ks = 0; ks < 2; ++ks) *(LAS bf16x8*)(Qs + ((size_t)(qrow + mi * 16 + fr) * 72 + ks * 32 + fq * 8) * 2) = *(const bf16x8*)(projb + (size_t)trow[mi] * PLD + C_Q + hh * 64 + ks * 32 + fq * 8);
    }
#define GATE(mi, i) sigmoidf_(bf2f(projb[(size_t)trow[mi] * PLD + C_GATE + hh * 3 + (i)]))
    f32x4 outa[2][4];
#pragma unroll
    for (int k = 0; k < 2; ++k) { const int idx = tid + k * 512;
        { const int row = idx >> 3, ch = idx & 7; *(LAS u32x4*)(Kc + ((size_t)row * 72 + ch * 8) * 2) = *(const u32x4*)(kcmp + row * 64 + ch * 8); }
        { const int row = idx >> 4, ch = idx & 15; *(LAS u32x4*)(VcT + ((size_t)row * 136 + ch * 8) * 2) = *(const u32x4*)(vcmpT + row * 128 + ch * 8); } }
    __syncthreads();
    {
        f32x4 S[2][8];
#pragma unroll
        for (int mi = 0; mi < 2; ++mi)
#pragma unroll
            for (int ni = 0; ni < 8; ++ni) S[mi][ni] = (f32x4){0.f, 0.f, 0.f, 0.f};
#pragma unroll
        for (int ks = 0; ks < 2; ++ks)
#pragma unroll
            for (int ni = 0; ni < 8; ++ni) { const bf16x8 kf = ldfrag(Kc, (ni * 16 + fr) * 72 + ks * 32 + fq * 8);
#pragma unroll
                for (int mi = 0; mi < 2; ++mi) S[mi][ni] = MF(kf, ldfrag(Qs, (qrow + mi * 16 + fr) * 72 + ks * 32 + fq * 8), S[mi][ni]); }
#pragma unroll
        for (int mi = 0; mi < 2; ++mi) { const int t = trow[mi]; float mx = -1e30f;
#pragma unroll
            for (int ni = 0; ni < 8; ++ni)
#pragma unroll
                for (int jj = 0; jj < 4; ++jj) { const int ci = ni * 16 + fq * 4 + jj; const bool valid = (16 * ci + 31 <= t);
                    const float s = valid ? S[mi][ni][jj] - slope * ((float)t - (16.f * (float)ci + 15.5f)) : -1e30f; S[mi][ni][jj] = s; mx = fmaxf(mx, s); }
            mx = fmaxf(mx, __shfl_xor(mx, 16)); mx = fmaxf(mx, __shfl_xor(mx, 32)); float sum = 0.f;
#pragma unroll
            for (int ni = 0; ni < 8; ++ni)
#pragma unroll
                for (int jj = 0; jj < 4; ++jj) { const float s = S[mi][ni][jj]; const float pv = s > -1e29f ? __builtin_amdgcn_exp2f(s - mx) : 0.f; S[mi][ni][jj] = pv; sum += pv; }
            sum += __shfl_xor(sum, 16); sum += __shfl_xor(sum, 32); const float inv = sum > 0.f ? 1.f / sum : 0.f;
#pragma unroll
            for (int ni = 0; ni < 8; ++ni) S[mi][ni] *= inv; }
#pragma unroll 1
        for (int rr = 0; rr < 4; ++rr) {
            if (r == rr) {
#pragma unroll
                for (int mi = 0; mi < 2; ++mi)
#pragma unroll
                    for (int ni = 0; ni < 8; ++ni) { LAS f32x4* dst = (LAS f32x4*)(Pc + (qh * 32 + mi * 16 + fr) * 132 + ni * 16 + fq * 4); if (rr == 0) *dst = S[mi][ni]; else *dst = *dst + S[mi][ni]; } }
            __syncthreads(); }
        bf16x8 pf[2][4];
#pragma unroll
        for (int mi = 0; mi < 2; ++mi)
#pragma unroll
            for (int ks2 = 0; ks2 < 4; ++ks2) pf[mi][ks2] = packfrag(S[mi][2 * ks2], S[mi][2 * ks2 + 1]);
        f32x4 O[2][4];
#pragma unroll
        for (int mi = 0; mi < 2; ++mi)
#pragma unroll
            for (int ei = 0; ei < 4; ++ei) O[mi][ei] = (f32x4){0.f, 0.f, 0.f, 0.f};
#pragma unroll
        for (int ks2 = 0; ks2 < 4; ++ks2)
#pragma unroll
            for (int ei = 0; ei < 4; ++ei) { const bf16x8 vf = ldfrag2(VcT, (ei * 16 + fr) * 136 + (2 * ks2) * 16 + fq * 4, (ei * 16 + fr) * 136 + (2 * ks2 + 1) * 16 + fq * 4);
#pragma unroll
                for (int mi = 0; mi < 2; ++mi) O[mi][ei] = MF(vf, pf[mi][ks2], O[mi][ei]); }
        const float g0v[2] = {GATE(0, 0), GATE(1, 0)};
#pragma unroll
        for (int mi = 0; mi < 2; ++mi)
#pragma unroll
            for (int ei = 0; ei < 4; ++ei) outa[mi][ei] = O[mi][ei] * g0v[mi];
    }
    if (wave == 0) { const int q = lane; const LAS float* pr = Pc + q * 132; float sc[32];
#pragma unroll
        for (int n = 0; n < 32; ++n) { float im = 0.f;
#pragma unroll
            for (int cc = 4 * n - 1; cc <= 4 * n + 3; ++cc) if (cc >= 0 && cc <= 126) im += pr[cc];
            const bool forced = (n == 0) || (n == cur) || (n == cur - 1);
            sc[n] = forced ? 1e9f : (n <= cur ? im : -1e30f); }
        unsigned mask = 0u;
#pragma unroll
        for (int it = 0; it < 8; ++it) { float best = -3e38f; int bi = 0;
#pragma unroll
            for (int n = 0; n < 32; ++n) if (sc[n] > best) { best = sc[n]; bi = n; }
            mask |= 1u << bi;
#pragma unroll
            for (int n = 0; n < 32; ++n) if (n == bi) sc[n] = -3e38f; }
        selm[q] = mask; }
    __syncthreads();
    unsigned U = selm[lane];
#pragma unroll
    for (int o = 32; o >= 1; o >>= 1) U |= __shfl_xor(U, o);
    U = __builtin_amdgcn_readfirstlane(U);
    const LAS unsigned* selq = selm + qh * 32;
    {
        float m[2] = {-1e30f, -1e30f}, ls[2] = {0.f, 0.f}; f32x4 O[2][4];
#pragma unroll
        for (int mi = 0; mi < 2; ++mi)
#pragma unroll
            for (int ei = 0; ei < 4; ++ei) O[mi][ei] = (f32x4){0.f, 0.f, 0.f, 0.f};
        { const unsigned Uv = cur >= 31 ? U : (U & ((2u << cur) - 1u));
          unsigned rem = Uv; int j = __builtin_ctz(rem); rem &= rem - 1u;
          u32x4 kr, vr; kv_load(kr, vr, projb, j, C_KS + g * 64, C_VS + g * 64, tid);
          kv_store(Ks, VT, kr, vr, tid); __syncthreads();
          int jn = rem ? __builtin_ctz(rem) : -1; rem &= rem - 1u;
          if (jn >= 0) kv_load(kr, vr, projb, jn, C_KS + g * 64, C_VS + g * 64, tid);
          int cb = 0;
#pragma unroll 1
          for (;;) {
              int jnn = -1;
              if (jn >= 0) { kv_store(cb ? Ks : Ks1, cb ? VT : VT1, kr, vr, tid); jnn = rem ? __builtin_ctz(rem) : -1; rem &= rem - 1u;
                  if (jnn >= 0) kv_load(kr, vr, projb, jnn, C_KS + g * 64, C_VS + g * 64, tid); }
              attn_tile<1>(cb ? Ks1 : Ks, cb ? VT1 : VT, Qs, qrow, trow, slope, j, j == cur, selq, m, ls, O, fr, fq);
              __syncthreads();
              if (jn < 0) break; j = jn; jn = jnn; cb ^= 1; } }
#pragma unroll
        for (int mi = 0; mi < 2; ++mi) { const float sc = GATE(mi, 1) / ls[mi];
#pragma unroll
            for (int ei = 0; ei < 4; ++ei) outa[mi][ei] += O[mi][ei] * sc; }
    }
    {
        float m[2] = {-1e30f, -1e30f}, ls[2] = {0.f, 0.f}; f32x4 O[2][4];
#pragma unroll
        for (int mi = 0; mi < 2; ++mi)
#pragma unroll
            for (int ei = 0; ei < 4; ++ei) O[mi][ei] = (f32x4){0.f, 0.f, 0.f, 0.f};
        { int j = cur > 4 ? cur - 4 : 0;
          u32x4 kr, vr; kv_load(kr, vr, projb, j, C_KW + g * 64, C_VW + g * 64, tid);
          kv_store(Ks, VT, kr, vr, tid); __syncthreads();
          if (j < cur) kv_load(kr, vr, projb, j + 1, C_KW + g * 64, C_VW + g * 64, tid);
          int cb = 0;
#pragma unroll 1
          for (;;) {
              if (j < cur) { kv_store(cb ? Ks : Ks1, cb ? VT : VT1, kr, vr, tid); if (j + 1 < cur) kv_load(kr, vr, projb, j + 2, C_KW + g * 64, C_VW + g * 64, tid); }
              attn_tile<2>(cb ? Ks1 : Ks, cb ? VT1 : VT, Qs, qrow, trow, slope, j, j == cur || j == cur - 4, selq, m, ls, O, fr, fq);
              __syncthreads();
              if (j >= cur) break; ++j; cb ^= 1; } }
#pragma unroll
        for (int mi = 0; mi < 2; ++mi) { const float sc = GATE(mi, 2) / ls[mi];
#pragma unroll
            for (int ei = 0; ei < 4; ++ei) outa[mi][ei] += O[mi][ei] * sc; }
    }
#pragma unroll
    for (int mi = 0; mi < 2; ++mi)
#pragma unroll
        for (int ei = 0; ei < 4; ++ei) { u32x2 o; o.x = pk2(outa[mi][ei][0], outa[mi][ei][1]); o.y = pk2(outa[mi][ei][2], outa[mi][ei][3]);
            *(u32x2*)(ys + ((size_t)b * SEQ + trow[mi]) * YLD + 1024 + hh * 64 + ei * 16 + fq * 4) = o; }
    __syncthreads();
}

__device__ __forceinline__ void convmod_item(const Params& p, int l, int item, lptr lds) {
    int tid_ = threadIdx.x; asm volatile("" : "+v"(tid_)); const int tid = tid_, wave = __builtin_amdgcn_readfirstlane(tid >> 6), lane = tid & 63;
    const int b = item >> 6, sp0 = (item & 63) * 32;
    const bf16_t* projb = (const bf16_t*)(p.ws + WS_PROJ) + (size_t)b * SEQ * PLD; bf16_t* ys = (bf16_t*)(p.ws + WS_YS);
    lptr glu = lds; LAS float* yf = (LAS float*)(lds + 63488);
#pragma unroll 4
    for (int idx = tid; idx < 62 * 64; idx += NT) { const int j = idx >> 6, c8 = (idx & 63) * 8; const int sp = sp0 - 30 + j; float o[8];
        if (sp >= 0) { float a[8], bb[8]; unpack8(*(const u32x4*)(projb + (size_t)sp * PLD + C_AB + c8), a); unpack8(*(const u32x4*)(projb + (size_t)sp * PLD + C_AB + 512 + c8), bb);
#pragma unroll
            for (int e = 0; e < 8; ++e) o[e] = a[e] * sigmoidf_(bb[e]); }
        else {
#pragma unroll
            for (int e = 0; e < 8; ++e) o[e] = 0.f; }
        *(LAS u32x4*)(glu + ((size_t)j * 512 + c8) * 2) = pack8(o); }
    __syncthreads();
    { const int cp = tid & 255, half = tid >> 8; const float* cw = p.in[I_CDW] + (size_t)l * 31 * 512 + 2 * cp;
      float w[31][2];
#pragma unroll
      for (int k = 0; k < 31; ++k) { const f32x2 t = *(const f32x2*)(cw + k * 512); w[k][0] = t.x; w[k][1] = t.y; }
      const f32x2 bs = *(const f32x2*)(p.in[I_CDB] + l * 512 + 2 * cp);
      float acc[16][2];
#pragma unroll
      for (int t = 0; t < 16; ++t) { acc[t][0] = bs.x; acc[t][1] = bs.y; }
#pragma unroll
      for (int jj = 0; jj < 46; ++jj) { const unsigned gw = *(const LAS unsigned*)(glu + ((size_t)(half * 16 + jj) * 512 + 2 * cp) * 2); const float g0 = lo16(gw), g1 = hi16(gw);
#pragma unroll
          for (int t = 0; t < 16; ++t) { const int k = jj - t; if (k >= 0 && k <= 30) { acc[t][0] += w[k][0] * g0; acc[t][1] += w[k][1] * g1; } } }
#pragma unroll
      for (int t = 0; t < 16; ++t) *(LAS f32x2*)(yf + (half * 16 + t) * 516 + 2 * cp) = (f32x2){acc[t][0], acc[t][1]}; }
    __syncthreads();
    for (int rr = 0; rr < 4; ++rr) { const int t = wave * 4 + rr; const LAS float* yr = yf + t * 516 + lane * 8; const f32x4 a = *(const LAS f32x4*)yr, bb = *(const LAS f32x4*)(yr + 4);
        float f[8] = {a.x, a.y, a.z, a.w, bb.x, bb.y, bb.z, bb.w}; float ss = 0.f;
#pragma unroll
        for (int e = 0; e < 8; ++e) ss += f[e] * f[e];
        ss = wave_sum(ss); const float rs = rsqrtf(ss * (1.f / 512.f) + EPS); const float* gn = p.in[I_CNORM] + l * 512 + lane * 8;
#pragma unroll
        for (int e = 0; e < 8; ++e) f[e] = siluf_(f[e] * rs * gn[e]);
        *(u32x4*)(ys + ((size_t)b * SEQ + sp0 + t) * YLD + 1536 + lane * 8) = pack8(f); }
    __syncthreads();
}

__global__ void __launch_bounds__(NT, 2) mega(Params p) {
    extern __shared__ __attribute__((aligned(16))) unsigned char lds_raw[];
    lptr lds = (lptr)lds_raw;
    cg::grid_group grid = cg::this_grid();
    int G = gridDim.x, c = blockIdx.x;
    unsigned char* ws = p.ws;
    volatile LAS unsigned* bst = (volatile LAS unsigned*)(lds + LDS_BYTES - 16);
    if (threadIdx.x < 4) bst[threadIdx.x] = 0u;
    __syncthreads();
    const XcdBarrier xbar = xcd_barrier_post((unsigned*)(p.ws + WS_BAR), bst);
    grid.sync();

#define OPQ() asm volatile("" : "+s"(G), "+s"(c), "+s"(l), "+s"(ws))
    bf16_t* xn = (bf16_t*)(ws + WS_XN); bf16_t* proj = (bf16_t*)(ws + WS_PROJ); bf16_t* hid = proj; unsigned char* gates = (unsigned char*)(ws + WS_GATES);
    bf16_t* ysb = (bf16_t*)(ws + WS_YS); float* mf = (float*)(ws + WS_PROJ); bf16_t* merged = (bf16_t*)(ws + WS_MERGED);
    float* x = p.out;
    const LAS float* rstl_c = (const LAS float*)(lds + 131072); LAS float* rstl = (LAS float*)(lds + 131072);
    float* rsqA = (float*)(ws + WS_RSQ); float* rsqB = rsqA + NTOK * 16; float* rsqC = rsqB + NTOK * 16;
    for (int li = 0; li < NLAYER; ++li) {
        int l = li; OPQ();
        const float* xin = l == 0 ? p.in[I_X] : x;
        if (l == 0) { convert_phase(p, 0, lds); norm_phase(xin, p.in[I_F1N], xn, rsqA);
            xcd_barrier(xbar); OPQ(); }
        { pg8::Gemm g{xn, (const bf16_t*)(ws + WS_W1IN), DM, DM}; pg8::StaticOrder S; S.init(NTOK, NFF, G, c); rstd_prologue(S, rsqA, rstl); pg8::EpiSwiglu E{hid, rstl}; pg8::gemm_phase(lds, g, S, E); }
        xcd_barrier(xbar); OPQ();
        { pg8::Gemm g{hid, (const bf16_t*)(ws + WS_W1OUT), FF, FF}; pg8::StaticOrder S; S.init(NTOK, DM, G, c); pg8::EpiResid E{xin, x, 0.5f, xn, p.in[I_MIXN] + l * DM, rsqB}; pg8::gemm_phase(lds, g, S, E); }
        xcd_barrier(xbar); OPQ();
        { pg8::Gemm g{xn, (const bf16_t*)(ws + WS_WIN), DM, DM}; pg8::StaticOrder S; S.init(NTOK, NIN, G, c); rstd_prologue(S, rsqB, rstl); pg8::EpiInproj E{proj, gates, rstl}; pg8::gemm_phase(lds, g, S, E); }
        xcd_barrier(xbar); OPQ();
        {
            if (MIX_MASK & 4) qknorm_pass(proj, p.in[I_QN] + l * 64, p.in[I_KN] + l * 64);
            constexpr int N_CMP = 64, N_SGU = 128, N_MB1 = 256, N_CV = 512, N_TOT = N_CMP + N_SGU + N_MB1 + N_CV;
            unsigned* ctr = (unsigned*)(ws + WS_BAR + 14336) + (l * 2) * 64;
            for (int it = c; it < N_TOT; ) { int r = it;
                unsigned nxt_it = 0u; if (threadIdx.x == 0) nxt_it = G + atomicAdd(ctr, 1u);
                if (r < N_CMP) { if (MIX_MASK & 4) compress_item(p, l, r, lds); }
                else if ((r -= N_CMP) < N_SGU) { if (MIX_MASK & 1) sgu_item(p, l, r, lds); }
                else if ((r -= N_SGU) < N_MB1) { if (MIX_MASK & 2) mamba1_item(p, l, r, lds); }
                else { r -= N_MB1; if (MIX_MASK & 8) convmod_item(p, l, r, lds); }
                if (threadIdx.x == 0) bst[2] = nxt_it;
                __syncthreads(); it = (int)bst[2]; __syncthreads(); }
        }
        xcd_barrier(xbar); OPQ();
        if (MIX_MASK & 2) prefix_phase(p);
        xcd_barrier(xbar); OPQ();
        {
            constexpr int N_MB2 = 128, N_ATT = 512, N_CVB = (CV_NB + 31) / 32, N_CVA = (CV_NA + 31) / 32;
            unsigned* ctr = (unsigned*)(ws + WS_BAR + 14336) + (l * 2 + 1) * 64;
            const int n_tot = N_MB2 + N_ATT + N_CVB + (l < NLAYER - 1 ? N_CVA : 0);
            for (int it = c; it < n_tot; ) { int r = it;
                unsigned nxt_it = 0u; if (threadIdx.x == 0) nxt_it = G + atomicAdd(ctr, 1u);
                if (r < N_MB2) { if (MIX_MASK & 2) mamba2_item(p, l, r, lds); }
                else if ((r -= N_MB2) < N_ATT) { const int qt = 31 - (r >> 4), bg = r & 15; if (MIX_MASK & 4) nsa_item(p, l, (bg << 5) | qt, lds); }
                else convert_wg_item(p, l, r - N_ATT, lds);
                if (threadIdx.x == 0) bst[2] = nxt_it;
                __syncthreads(); it = (int)bst[2]; __syncthreads(); }
        }
        xcd_barrier(xbar); OPQ();
        { pg8::Gemm g{ysb, (const bf16_t*)(ws + WS_WB), YLD, 512}; pg8::MergeOrder S; S.init(G, c); pg8::EpiMerge E{gates, merged}; pg8::gemm_phase(lds, g, S, E); }
        xcd_barrier(xbar); OPQ();
        { pg8::Gemm g{merged, (const bf16_t*)(ws + WS_WO), DM, DM}; pg8::StaticOrder S; S.init(NTOK, DM, G, c); pg8::EpiResid E{x, x, 1.0f, xn, p.in[I_F2N] + l * DM, rsqC}; pg8::gemm_phase(lds, g, S, E); }
        xcd_barrier(xbar); OPQ();
        { pg8::Gemm g{xn, (const bf16_t*)(ws + WS_W2IN), DM, DM}; pg8::StaticOrder S; S.init(NTOK, NFF, G, c); rstd_prologue(S, rsqC, rstl); pg8::EpiSwiglu E{hid, rstl}; pg8::gemm_phase(lds, g, S, E); }
        xcd_barrier(xbar); OPQ();
        { const bool lastl = (l == NLAYER - 1); pg8::Gemm g{hid, (const bf16_t*)(ws + WS_W2OUT), FF, FF}; pg8::StaticOrder S; S.init(NTOK, DM, G, c);
          pg8::EpiResid E{x, x, 0.5f, lastl ? (bf16_t*)nullptr : xn, p.in[I_F1N] + (lastl ? l : l + 1) * DM, rsqA}; pg8::gemm_phase(lds, g, S, E); }
        xcd_barrier(xbar); OPQ();
    }
}

extern "C" void kernel_launch(void* const* d_in, const int* in_sizes, int n_in, void* d_out, int out_size, void* d_ws, size_t ws_size, hipStream_t stream) {
    static int grid_blocks = 0;
    if (grid_blocks == 0) {
        if (n_in != 31 || out_size != NTOK * DM || ws_size < WS_END) { fprintf(stderr, "kernel_launch: unexpected shapes (n_in %d, out %d, ws %zu need %zu)\n", n_in, out_size, ws_size, (size_t)WS_END); grid_blocks = -1; return; }
        int dev = 0, cus = 0, per_cu = 0;
        hipGetDevice(&dev);
        hipDeviceGetAttribute(&cus, hipDeviceAttributeMultiprocessorCount, dev);
        if (hipFuncSetAttribute((const void*)mega, hipFuncAttributeMaxDynamicSharedMemorySize, LDS_BYTES) != hipSuccess) { fprintf(stderr, "kernel_launch: hipFuncSetAttribute failed\n"); grid_blocks = -1; return; }
        if (hipOccupancyMaxActiveBlocksPerMultiprocessor(&per_cu, (const void*)mega, NT, LDS_BYTES) != hipSuccess || per_cu < 1) { fprintf(stderr, "kernel_launch: occupancy query gave %d\n", per_cu); per_cu = 1; }
        (void)hipGetLastError();
        grid_blocks = cus * 1;
        (void)per_cu;
    }
    if (grid_blocks < 0) return;
    Params p{};
    for (int i = 0; i < 31; ++i) p.in[i] = (const float*)d_in[i];
    p.out = (float*)d_out; p.ws = (unsigned char*)d_ws;
    if (hipMemsetAsync((char*)d_ws + WS_BAR, 0, 16384, stream) != hipSuccess) { fprintf(stderr, "kernel_launch: memset failed\n"); return; }
    void* args[] = {&p};
    hipError_t e = hipLaunchCooperativeKernel((const void*)mega, dim3(grid_blocks), dim3(NT), args, LDS_BYTES, stream);
    if (e != hipSuccess) fprintf(stderr, "cooperative launch failed: %s (grid %d)\n", hipGetErrorString(e), grid_blocks);
}
```
